# Optimizing an MI355X kernel written in HIP

```python
import math
import jax
import jax.numpy as jnp
from jax import lax
import numpy as np

D_MODEL = 1024
BATCH = 4
SEQ = 4096
DEPTH = 4

GRID_W = 64
CTX_LEN = 256
D_MIX = D_MODEL
D_FF = 2816
N_MOD = 9
EPS = 1e-6

GLA_H = 4
GLA_DK = 32
GLA_DV = 64
GLA_LORA = 16
GLA_TAU = 16.0
GLA_CHUNK = 64
SSM_H = 4
SSM_P = 64
SSM_G = 2
SSM_N = 64
SSM_CONV = 3
SSM_CHUNK = 64
SSM_DI = SSM_H * SSM_P
SSM_CONV_CH = SSM_DI + 2 * SSM_G * SSM_N
RWKV_H = 4
RWKV_N = 64
RWKV_D = RWKV_H * RWKV_N
RWKV_W_LORA = 64
RWKV_A_LORA = 64
RWKV_G_LORA = 128
RWKV_GN_EPS = 64e-5
ATT_HQ = 4
ATT_HKV = 2
ATT_GROUP = ATT_HQ // ATT_HKV
ATT_HD = 64
ATT_BLOCK = 128
ROPE_THETA = 10000.0
ROPE_AXIS_DIM = ATT_HD // 2

GLA_COLS = [GLA_H * GLA_DK, GLA_H * GLA_DK, GLA_H * GLA_DV, GLA_H * GLA_DV, GLA_LORA]
SSM_COLS = [SSM_DI, SSM_CONV_CH, SSM_H]
RWKV_COLS = [RWKV_D, RWKV_D, RWKV_D, RWKV_W_LORA, RWKV_A_LORA, RWKV_G_LORA]
ATT_COLS = [ATT_HQ * ATT_HD, ATT_HKV * ATT_HD, ATT_HKV * ATT_HD]
GROUP_COLS = [sum(GLA_COLS), sum(SSM_COLS), sum(RWKV_COLS), sum(ATT_COLS)]
N_IN = sum(GROUP_COLS)

kernel_name = 'hybrid_parallel_group_dit_trunk'


def split_cols(u, sizes):
    out, start = [], 0
    for s in sizes:
        out.append(u[..., start:start + s])
        start += s
    return out


def rms_norm(x, g, eps=EPS):
    xf = x.astype(jnp.float32)
    y = xf * lax.rsqrt(jnp.mean(xf * xf, axis=-1, keepdims=True) + eps)
    return (y * g.astype(jnp.float32)).astype(x.dtype)


def modulate(h, g, shift, scale):
    return rms_norm(h, g) * (1 + scale[:, None]) + shift[:, None]


def swiglu(h, w_in, w_out):
    a, b = jnp.split(h @ w_in, 2, axis=-1)
    return (jax.nn.silu(a) * b) @ w_out


def _ident(t):
    return t


def _flip(t):
    return jnp.flip(t, axis=1)


def shift_prev(u):
    return jnp.pad(u, ((0, 0), (1, 0), (0, 0)))[:, :-1]


def shift_next(u):
    return jnp.pad(u, ((0, 0), (0, 1), (0, 0)))[:, 1:]


def dwconv_centred(u, w, b):
    pad = w.shape[0] // 2
    y = lax.conv_general_dilated(u, w[:, None, :].astype(u.dtype), window_strides=(1,),
                                 padding=[(pad, pad)], dimension_numbers=('NWC', 'WIO', 'NWC'),
                                 feature_group_count=u.shape[-1])
    return y + b


def axial_rope_tables(n_tokens, dtype):
    rows = n_tokens // GRID_W
    f32 = jnp.float32
    row = jnp.repeat(jnp.arange(rows, dtype=f32), GRID_W)
    col = jnp.tile(jnp.arange(GRID_W, dtype=f32), rows)
    inv = ROPE_THETA ** (-jnp.arange(0, ROPE_AXIS_DIM, 2, dtype=f32) / ROPE_AXIS_DIM)
    ang = jnp.stack([row[:, None] * inv, col[:, None] * inv], axis=1)
    return jnp.cos(ang).astype(dtype), jnp.sin(ang).astype(dtype)


def apply_axial_rope(t, cos, sin):
    bsz, n, h, d = t.shape
    t = t.reshape(bsz, n, h, 2, 2, ROPE_AXIS_DIM // 2)
    t1, t2 = t[..., 0, :], t[..., 1, :]
    c, s = cos[None, :, None], sin[None, :, None]
    out = jnp.stack([t1 * c - t2 * s, t1 * s + t2 * c], axis=-2)
    return out.reshape(bsz, n, h, d)


def gla_chunked(q, k, v, log_a, s0):
    bsz, t, h, dk = q.shape
    dv = v.shape[-1]
    cs = GLA_CHUNK
    nc = t // cs
    q, k, v, log_a = [z.reshape(bsz, nc, cs, h, z.shape[-1]) for z in (q, k, v, log_a)]
    b = jnp.cumsum(log_a, axis=2)
    b_last = b[:, :, -1:]
    q_dec = q * jnp.exp(b)
    causal = jnp.tril(jnp.ones((cs, cs), bool))
    att = jnp.einsum('bnthd,bnshd->bnhts', q_dec, k * jnp.exp(-b))
    att = jnp.where(causal, att, 0.0)
    o_intra = jnp.einsum('bnhts,bnshv->bnthv', att, v)
    chunk_state = jnp.einsum('bnshd,bnshv->bnhdv', k * jnp.exp(b_last - b), v)
    chunk_decay = jnp.exp(b_last[:, :, 0])

    def step(s, inp):
        st, dec = inp
        return s * dec[..., None] + st, s

    s_fin, s_prev = lax.scan(step, s0, (jnp.moveaxis(chunk_state, 1, 0), jnp.moveaxis(chunk_decay, 1, 0)))
    s_prev = jnp.moveaxis(s_prev, 0, 1)
    o_inter = jnp.einsum('bnthd,bnhdv->bnthv', q_dec, s_prev)
    return (o_intra + o_inter).reshape(bsz, t, h, dv), s_fin


def gla_mixer(u_c, u_x, w_dec, b_dec, norm_g, need_ctx):
    f32 = jnp.float32

    def streams(u):
        bsz, t, _ = u.shape
        q, k, v, g, lr = split_cols(u, GLA_COLS)
        q = q.reshape(bsz, t, GLA_H, GLA_DK).astype(f32) * (GLA_DK ** -0.5)
        k = k.reshape(bsz, t, GLA_H, GLA_DK).astype(f32)
        v = v.reshape(bsz, t, GLA_H, GLA_DV).astype(f32)
        return q, k, v, g, lr

    def log_decay(lr, d):
        z = (lr @ w_dec[d] + b_dec[d]).astype(f32)
        return (jax.nn.log_sigmoid(z) / GLA_TAU).reshape(lr.shape[0], lr.shape[1], GLA_H, GLA_DK)

    def finish(o, g):
        bsz, t = o.shape[:2]
        o = rms_norm(o, norm_g).reshape(bsz, t, GLA_H * GLA_DV)
        return o.astype(g.dtype) * jax.nn.silu(g)

    qc, kc, vc, gc, lc = streams(u_c)
    qx, kx, vx, gx, lx = streams(u_x)
    bsz = u_x.shape[0]
    o_c = jnp.zeros_like(vc)
    o_x = jnp.zeros_like(vx)
    for d in range(2):
        fl = _flip if d else _ident
        s0 = jnp.zeros((bsz, GLA_H, GLA_DK, GLA_DV), f32)
        oc, s_ctx = gla_chunked(fl(qc), fl(kc), fl(vc), fl(log_decay(lc, d)), s0)
        ox, _ = gla_chunked(fl(qx), fl(kx), fl(vx), fl(log_decay(lx, d)), s_ctx)
        o_c = o_c + fl(oc)
        o_x = o_x + fl(ox)
    y_c = finish(o_c, gc) if need_ctx else None
    return y_c, finish(o_x, gx)


def ssd_chunked(xs, dt, a, bm, cm, h0):
    bsz, t, h, p = xs.shape
    g, n = bm.shape[-2:]
    r = h // g
    cs = SSM_CHUNK
    nc = t // cs
    xdt = (xs * dt[..., None]).reshape(bsz, nc, cs, g, r, p)
    cum = jnp.cumsum((dt * a).reshape(bsz, nc, cs, g, r), axis=2)
    bc = bm.reshape(bsz, nc, cs, g, n)
    cc = cm.reshape(bsz, nc, cs, g, n)
    cum_t = jnp.moveaxis(cum, 2, -1)
    mask = jnp.tril(jnp.ones((cs, cs), bool))
    seg = jnp.exp(jnp.where(mask, cum_t[..., :, None] - cum_t[..., None, :], -jnp.inf))
    cb = jnp.einsum('bctgn,bcsgn->bcgts', cc, bc)
    y_intra = jnp.einsum('bcgts,bcgrts,bcsgrp->bctgrp', cb, seg, xdt)
    last = cum[:, :, -1]
    to_end = jnp.exp(last[:, :, None] - cum)
    chunk_state = jnp.einsum('bcsgn,bcsgr,bcsgrp->bcgrpn', bc, to_end, xdt)

    def step(hs, inp):
        st, dec = inp
        return hs * dec[..., None, None] + st, hs

    h_fin, h_prev = lax.scan(step, h0, (jnp.moveaxis(chunk_state, 1, 0), jnp.moveaxis(jnp.exp(last), 1, 0)))
    h_prev = jnp.moveaxis(h_prev, 0, 1)
    y_inter = jnp.einsum('bctgn,bctgr,bcgrpn->bctgrp', cc, jnp.exp(cum), h_prev)
    return (y_intra + y_inter).reshape(bsz, t, h, p), h_fin


def mamba_mixer(u_c, u_x, conv_w, conv_b, dt_bias, a_log, d_skip, norm_g, need_ctx):
    f32 = jnp.float32

    def streams(u):
        bsz, t, _ = u.shape
        z, xbc, dt = split_cols(u, SSM_COLS)
        xbc = jax.nn.silu(dwconv_centred(xbc, conv_w, conv_b))
        xs, bm, cm = split_cols(xbc, [SSM_DI, SSM_G * SSM_N, SSM_G * SSM_N])
        return (z, xs.reshape(bsz, t, SSM_H, SSM_P).astype(f32),
                bm.reshape(bsz, t, SSM_G, SSM_N).astype(f32),
                cm.reshape(bsz, t, SSM_G, SSM_N).astype(f32), dt.astype(f32))

    def finish(y, z, xs):
        bsz, t = y.shape[:2]
        y = y + d_skip.astype(f32)[:, None] * xs
        y = y.reshape(bsz, t, SSM_DI) * jax.nn.silu(z.astype(f32))
        return rms_norm(y, norm_g).astype(z.dtype)

    zc, xc, bc, cc, dtc = streams(u_c)
    zx, xx, bx, cx, dtx = streams(u_x)
    bsz = u_x.shape[0]
    y_c = jnp.zeros_like(xc)
    y_x = jnp.zeros_like(xx)
    for d in range(2):
        fl = _flip if d else _ident
        a = -jnp.exp(a_log[d].astype(f32))
        bias = dt_bias[d].astype(f32)
        h0 = jnp.zeros((bsz, SSM_G, SSM_H // SSM_G, SSM_P, SSM_N), f32)
        yc, h_ctx = ssd_chunked(fl(xc), fl(jax.nn.softplus(dtc + bias)), a, fl(bc), fl(cc), h0)
        yx, _ = ssd_chunked(fl(xx), fl(jax.nn.softplus(dtx + bias)), a, fl(bx), fl(cx), h_ctx)
        y_c = y_c + fl(yc)
        y_x = y_x + fl(yx)
    out_c = finish(y_c, zc, xc) if need_ctx else None
    return out_c, finish(y_x, zx, xx)


def rwkv7_scan(r, w, k, v, a_in, b_in, s0):
    def step(s, inp):
        r_t, w_t, k_t, v_t, a_t, b_t = inp
        sa = jnp.einsum('bhij,bhj->bhi', s, a_t)
        s = s * w_t[:, :, None, :] + sa[..., None] * b_t[:, :, None, :] + v_t[..., None] * k_t[:, :, None, :]
        return s, jnp.einsum('bhij,bhj->bhi', s, r_t)

    seq = tuple(jnp.moveaxis(z, 1, 0) for z in (r, w, k, v, a_in, b_in))
    s_fin, y = lax.scan(step, s0, seq)
    return jnp.moveaxis(y, 0, 1), s_fin


def rwkv_mixer(u_c, u_x, shift_mu, w0, w_dec, a0, w_a, w_g, k_k, k_a, r_k, ln_g, ln_b, need_ctx):
    f32 = jnp.float32

    def streams(u):
        bsz, t, _ = u.shape
        u = u + shift_mu[0] * (shift_prev(u) - u) + shift_mu[1] * (shift_next(u) - u)
        r, k, v, lw, la, lg = split_cols(u, RWKV_COLS)
        heads = lambda z: z.reshape(bsz, t, RWKV_H, RWKV_N).astype(f32)
        a = jax.nn.sigmoid(a0 + la @ w_a)
        g = jax.nn.sigmoid(lg) @ w_g
        kk = heads(k * k_k)
        kk = kk / jnp.maximum(jnp.sqrt(jnp.sum(kk * kk, axis=-1, keepdims=True)), 1e-12)
        k = k * (1 + (a - 1) * k_a)
        return heads(r), heads(k), heads(v), heads(a), kk, jnp.tanh(lw), g

    def log_decay(tlw, d):
        wr = (w0[d] + tlw @ w_dec[d]).astype(f32)
        wr = -jax.nn.softplus(-wr) - 0.5
        return (-jnp.exp(wr)).reshape(tlw.shape[0], tlw.shape[1], RWKV_H, RWKV_N)

    def finish(y, r, k, v, g):
        bsz, t = y.shape[:2]
        mu = jnp.mean(y, axis=-1, keepdims=True)
        var = jnp.mean(jnp.square(y - mu), axis=-1, keepdims=True)
        y = ((y - mu) * lax.rsqrt(var + RWKV_GN_EPS)).reshape(bsz, t, RWKV_D) * ln_g + ln_b
        bonus = jnp.sum(r * k * r_k.astype(f32), axis=-1, keepdims=True) * v
        y = y + bonus.reshape(bsz, t, RWKV_D)
        return (y * g.astype(f32)).astype(g.dtype)

    rc, kc, vc, ac, kkc, tc, gc = streams(u_c)
    rx, kx, vx, ax, kkx, tx, gx = streams(u_x)
    bsz = u_x.shape[0]
    y_c = jnp.zeros_like(vc)
    y_x = jnp.zeros_like(vx)
    for d in range(2):
        fl = _flip if d else _ident
        s0 = jnp.zeros((bsz, RWKV_H, RWKV_N, RWKV_N), f32)
        yc, s_ctx = rwkv7_scan(fl(rc), fl(jnp.exp(log_decay(tc, d))), fl(kc), fl(vc), fl(-kkc), fl(kkc * ac), s0)
        yx, _ = rwkv7_scan(fl(rx), fl(jnp.exp(log_decay(tx, d))), fl(kx), fl(vx), fl(-kkx), fl(kkx * ax), s_ctx)
        y_c = y_c + fl(yc)
        y_x = y_x + fl(yx)
    out_c = finish(y_c, rc, kc, vc, gc) if need_ctx else None
    return out_c, finish(y_x, rx, kx, vx, gx)


def gqa_attend(q, k, v):
    s = jnp.einsum('bqkgd,bskd->bkgqs', q, k).astype(jnp.float32) * (ATT_HD ** -0.5)
    p = jax.nn.softmax(s, axis=-1)
    return jnp.einsum('bkgqs,bskd->bqkgd', p.astype(v.dtype), v)


def attention_mixer(u_c, u_x, q_norm, k_norm, cos, sin, need_ctx):
    def streams(u):
        bsz, t, _ = u.shape
        q, k, v = split_cols(u, ATT_COLS)
        q = rms_norm(q.reshape(bsz, t, ATT_HQ, ATT_HD), q_norm)
        k = rms_norm(k.reshape(bsz, t, ATT_HKV, ATT_HD), k_norm)
        return q, k, v.reshape(bsz, t, ATT_HKV, ATT_HD)

    qc, kc, vc = streams(u_c)
    qx, kx, vx = streams(u_x)
    qx = apply_axial_rope(qx, cos, sin)
    kx = apply_axial_rope(kx, cos, sin)
    keys = jnp.concatenate([kx, kc], axis=1)
    vals = jnp.concatenate([vx, vc], axis=1)
    bsz, t = qx.shape[:2]
    nb = t // ATT_BLOCK
    q_blocks = jnp.moveaxis(qx.reshape(bsz, nb, ATT_BLOCK, ATT_HKV, ATT_GROUP, ATT_HD), 1, 0)
    y_x = lax.map(lambda qb: gqa_attend(qb, keys, vals), q_blocks)
    y_x = jnp.moveaxis(y_x, 0, 1).reshape(bsz, t, ATT_HQ * ATT_HD)
    y_c = None
    if need_ctx:
        lc = qc.shape[1]
        y_c = gqa_attend(qc.reshape(bsz, lc, ATT_HKV, ATT_GROUP, ATT_HD), kc, vc).reshape(bsz, lc, ATT_HQ * ATT_HD)
    return y_c, y_x


def hybrid_layer(x, ctx, mod_x, mod_c, cos, sin, p, need_ctx):
    mx = jnp.split(mod_x, N_MOD, axis=-1)
    mc = jnp.split(mod_c, N_MOD, axis=-1)
    x = x + 0.5 * mx[2][:, None] * swiglu(modulate(x, p['norm_g'][0], mx[0], mx[1]), p['ffn_in'][0], p['ffn_out'][0])
    ctx = ctx + 0.5 * mc[2][:, None] * swiglu(modulate(ctx, p['norm_g'][0], mc[0], mc[1]), p['ffn_in'][0], p['ffn_out'][0])
    ux = modulate(x, p['norm_g'][1], mx[3], mx[4]) @ p['w_in']
    uc = modulate(ctx, p['norm_g'][1], mc[3], mc[4]) @ p['w_in']
    gx = split_cols(ux, GROUP_COLS)
    gc = split_cols(uc, GROUP_COLS)
    gla_c, gla_x = gla_mixer(gc[0], gx[0], p['gla_w_dec'], p['gla_b_dec'], p['gla_norm'], need_ctx)
    ssm_c, ssm_x = mamba_mixer(gc[1], gx[1], p['ssm_conv_w'], p['ssm_conv_b'], p['ssm_dt_bias'],
                               p['ssm_a_log'], p['ssm_d'], p['ssm_norm'], need_ctx)
    rw_c, rw_x = rwkv_mixer(gc[2], gx[2], p['rwkv_shift_mu'], p['rwkv_w0'], p['rwkv_w_dec'], p['rwkv_a0'],
                            p['rwkv_w_a'], p['rwkv_w_g'], p['rwkv_k_k'], p['rwkv_k_a'], p['rwkv_r_k'],
                            p['rwkv_ln_g'], p['rwkv_ln_b'], need_ctx)
    at_c, at_x = attention_mixer(gc[3], gx[3], p['att_q_norm'], p['att_k_norm'], cos, sin, need_ctx)
    x = x + mx[5][:, None] * (jnp.concatenate([gla_x, ssm_x, rw_x, at_x], axis=-1) @ p['w_out'])
    if need_ctx:
        ctx = ctx + mc[5][:, None] * (jnp.concatenate([gla_c, ssm_c, rw_c, at_c], axis=-1) @ p['w_out'])
        ctx = ctx + 0.5 * mc[8][:, None] * swiglu(modulate(ctx, p['norm_g'][2], mc[6], mc[7]), p['ffn_in'][1], p['ffn_out'][1])
    x = x + 0.5 * mx[8][:, None] * swiglu(modulate(x, p['norm_g'][2], mx[6], mx[7]), p['ffn_in'][1], p['ffn_out'][1])
    return x, ctx


def setup_inputs(seed: int = 0) -> dict:
    key = jax.random.key(seed)
    keys = jax.random.split(key, 40)
    counter = [0]
    f32 = jnp.float32

    def nk():
        k = keys[counter[0]]
        counter[0] += 1
        return k

    def nrm(shape, scale):
        return jax.random.normal(nk(), shape, f32) * scale

    def unif(shape, lo, hi):
        return jax.random.uniform(nk(), shape, f32, lo, hi)

    L, D = DEPTH, D_MODEL
    x = nrm((BATCH, SEQ, D), 1.0)
    c = nrm((BATCH, D), 1.0)
    ctx = nrm((BATCH, CTX_LEN, D), 1.0)
    c_ctx = nrm((D,), 1.0)
    norm_g = 1.0 + nrm((L, 3, D), 0.1)
    w_mod = nrm((L, D, N_MOD * D), 0.5 * D ** -0.5)
    b_mod = nrm((L, N_MOD * D), 0.02)
    ffn_in = nrm((L, 2, D, 2 * D_FF), D ** -0.5)
    ffn_out = nrm((L, 2, D_FF, D), D_FF ** -0.5)
    w_in = nrm((L, D, N_IN), D ** -0.5)
    w_out = nrm((L, D_MIX, D), D_MIX ** -0.5)
    gla_w_dec = nrm((L, 2, GLA_LORA, GLA_H * GLA_DK), GLA_LORA ** -0.5)
    gla_b_dec = nrm((L, 2, GLA_H * GLA_DK), 0.5)
    gla_norm = 1.0 + nrm((L, GLA_DV), 0.1)
    ssm_conv_w = nrm((L, SSM_CONV, SSM_CONV_CH), SSM_CONV ** -0.5)
    ssm_conv_b = nrm((L, SSM_CONV_CH), 0.02)
    dt0 = jnp.exp(unif((L, 2, SSM_H), math.log(1e-3), math.log(1e-1)))
    ssm_dt_bias = dt0 + jnp.log(-jnp.expm1(-dt0))
    ssm_a_log = jnp.log(unif((L, 2, SSM_H), 1.0, 16.0))
    ssm_d = 1.0 + nrm((L, SSM_H), 0.1)
    ssm_norm = 1.0 + nrm((L, SSM_DI), 0.1)
    rwkv_shift_mu = unif((L, 2, sum(RWKV_COLS)), 0.0, 0.5)
    rwkv_w0 = unif((L, 2, RWKV_D), -3.0, 1.0)
    rwkv_w_dec = nrm((L, 2, RWKV_W_LORA, RWKV_D), 0.5 * RWKV_W_LORA ** -0.5)
    rwkv_a0 = nrm((L, RWKV_D), 0.1)
    rwkv_w_a = nrm((L, RWKV_A_LORA, RWKV_D), RWKV_A_LORA ** -0.5)
    rwkv_w_g = nrm((L, RWKV_G_LORA, RWKV_D), RWKV_G_LORA ** -0.5)
    rwkv_k_k = 0.85 + nrm((L, RWKV_D), 0.05)
    rwkv_k_a = 1.0 + nrm((L, RWKV_D), 0.05)
    rwkv_r_k = nrm((L, RWKV_H, RWKV_N), 0.1)
    rwkv_ln_g = 1.0 + nrm((L, RWKV_D), 0.1)
    rwkv_ln_b = nrm((L, RWKV_D), 0.02)
    att_q_norm = 1.0 + nrm((L, ATT_HD), 0.1)
    att_k_norm = 1.0 + nrm((L, ATT_HD), 0.1)
    return {'x': x, 'c': c, 'ctx': ctx, 'c_ctx': c_ctx, 'norm_g': norm_g, 'w_mod': w_mod, 'b_mod': b_mod,
            'ffn_in': ffn_in, 'ffn_out': ffn_out, 'w_in': w_in, 'w_out': w_out,
            'gla_w_dec': gla_w_dec, 'gla_b_dec': gla_b_dec, 'gla_norm': gla_norm,
            'ssm_conv_w': ssm_conv_w, 'ssm_conv_b': ssm_conv_b, 'ssm_dt_bias': ssm_dt_bias,
            'ssm_a_log': ssm_a_log, 'ssm_d': ssm_d, 'ssm_norm': ssm_norm,
            'rwkv_shift_mu': rwkv_shift_mu, 'rwkv_w0': rwkv_w0, 'rwkv_w_dec': rwkv_w_dec, 'rwkv_a0': rwkv_a0,
            'rwkv_w_a': rwkv_w_a, 'rwkv_w_g': rwkv_w_g, 'rwkv_k_k': rwkv_k_k, 'rwkv_k_a': rwkv_k_a,
            'rwkv_r_k': rwkv_r_k, 'rwkv_ln_g': rwkv_ln_g, 'rwkv_ln_b': rwkv_ln_b,
            'att_q_norm': att_q_norm, 'att_k_norm': att_k_norm}


def reference(x, c, ctx, c_ctx, norm_g, w_mod, b_mod, ffn_in, ffn_out, w_in, w_out,
              gla_w_dec, gla_b_dec, gla_norm, ssm_conv_w, ssm_conv_b, ssm_dt_bias, ssm_a_log, ssm_d, ssm_norm,
              rwkv_shift_mu, rwkv_w0, rwkv_w_dec, rwkv_a0, rwkv_w_a, rwkv_w_g, rwkv_k_k, rwkv_k_a, rwkv_r_k,
              rwkv_ln_g, rwkv_ln_b, att_q_norm, att_k_norm):
    cos, sin = axial_rope_tables(x.shape[1], x.dtype)
    sc = jax.nn.silu(c)
    scc = jax.nn.silu(c_ctx)[None]
    for l in range(DEPTH):
        mod_x = sc @ w_mod[l] + b_mod[l]
        mod_c = scc @ w_mod[l] + b_mod[l]
        p = dict(norm_g=norm_g[l], ffn_in=ffn_in[l], ffn_out=ffn_out[l], w_in=w_in[l], w_out=w_out[l],
                 gla_w_dec=gla_w_dec[l], gla_b_dec=gla_b_dec[l], gla_norm=gla_norm[l],
                 ssm_conv_w=ssm_conv_w[l], ssm_conv_b=ssm_conv_b[l], ssm_dt_bias=ssm_dt_bias[l],
                 ssm_a_log=ssm_a_log[l], ssm_d=ssm_d[l], ssm_norm=ssm_norm[l],
                 rwkv_shift_mu=rwkv_shift_mu[l], rwkv_w0=rwkv_w0[l], rwkv_w_dec=rwkv_w_dec[l],
                 rwkv_a0=rwkv_a0[l], rwkv_w_a=rwkv_w_a[l], rwkv_w_g=rwkv_w_g[l], rwkv_k_k=rwkv_k_k[l],
                 rwkv_k_a=rwkv_k_a[l], rwkv_r_k=rwkv_r_k[l], rwkv_ln_g=rwkv_ln_g[l], rwkv_ln_b=rwkv_ln_b[l],
                 att_q_norm=att_q_norm[l], att_k_norm=att_k_norm[l])
        x, ctx = hybrid_layer(x, ctx, mod_x, mod_c, cos, sin, p, l < DEPTH - 1)
    return x
```

```cpp
#include <hip/hip_runtime.h>
#include <hip/hip_cooperative_groups.h>
#include <cstdio>
#include <cstdint>
namespace cg = cooperative_groups;
constexpr int D = 1024, NBATCH = 4, SEQ = 4096, DEPTH = 4, CTXL = 256;
constexpr int TL = NBATCH * SEQ, TC = NBATCH * CTXL, T = TL + TC;
constexpr int DFF = 2816, NUP = 2 * DFF, NIN = 3092, NINP = 3328, NMODC = 9 * D;
namespace pg8 {
#define PG8_LAS __attribute__((address_space(3)))
typedef unsigned short bf16_t;
typedef short bf16x8 __attribute__((ext_vector_type(8)));
typedef float f32x4 __attribute__((ext_vector_type(4)));
typedef unsigned u32x4 __attribute__((ext_vector_type(4)));
constexpr int BM = 256, BK = 64, HALF = 128, HTB = HALF * BK * 2  , STAGE_BYTES = 8 * HTB, NXCD = 8, WGM = 8;

__host__ __device__ __forceinline__ int lds_byte(int r, int c) { const int st = (r >> 4) * 2 + (c >> 5), rr = r & 15, cc = c & 31, ob = rr * 64 + cc * 2; return st * 1024 + (ob ^ (((ob >> 9) & 1) << 5)); }
__host__ __device__ __forceinline__ void stage_rc(int b, int& R, int& C) { const int st = b / 1024, sb = b % 1024, swz = sb ^ (((sb >> 9) & 1) << 5); R = (st >> 1) * 16 + swz / 64; C = (st & 1) * 32 + (swz % 64) / 2; }
__host__ __device__ __forceinline__ int perm32(int rho) { const int n = rho >> 4, i = rho & 15; return 8 * (i >> 2) + 4 * n + (i & 3); }

struct Unit { int pm, pn; };
struct Gemm { const bf16_t* A; const bf16_t* Bt; int M, N, K; };

struct StaticOrder {
    int nM, nN, nwg, G, c;
    __host__ __device__ void init(int M, int N, int G_, int c_) { nM = M / BM; nN = N / BM; nwg = nM * nN; G = G_; c = c_; }
    __host__ __device__ bool next(int i, Unit& u) const {
        const long L = (long)i * G + c; if (L >= nwg) return false;
        int wgid = (int)L; { const int q = nwg / NXCD, r = nwg % NXCD, xcd = wgid % NXCD, off = wgid / NXCD; wgid = (xcd < r ? xcd * (q + 1) : r * (q + 1) + (xcd - r) * q) + off; }
        const int nig = WGM * nN, gid = wgid / nig, fm = gid * WGM, gsz = (nM - fm) < WGM ? (nM - fm) : WGM;
        u.pm = fm + ((wgid % nig) % gsz); u.pn = (wgid % nig) / gsz; return true;
    }
    __device__ __forceinline__ void a_ready(const Unit&) const {}
    __device__ __forceinline__ void done(const Unit&) const {}
};
__device__ __forceinline__ unsigned cvt_pk_bf16(float lo, float hi) { unsigned r; asm volatile("v_cvt_pk_bf16_f32 %0, %1, %2" : "=v"(r) : "v"(lo), "v"(hi)); return r; }
typedef float f32x2 __attribute__((ext_vector_type(2)));
__device__ __forceinline__ float silu_fast(float a) { return a * __builtin_amdgcn_rcpf(1.0f + __builtin_amdgcn_exp2f(-1.44269504f * a)); }
struct EpiSwiglu {
    static constexpr bool PERM = true, AFTER_DRAIN = false;
    bf16_t* O; int ldc;
    __device__ __forceinline__ void operator()(const f32x4 (&acc)[2][2][4][2], const Unit& u, int wr, int wc, int fr, int fq) const {
        const int row0 = u.pm * BM + wr * 64 + fr, col0 = u.pn * HALF + wc * 32 + 8 * fq;
#pragma unroll
        for (int ai = 0; ai < 2; ++ai)
#pragma unroll
            for (int m = 0; m < 4; ++m) {
                bf16_t* rowp = O + (size_t)(row0 + ai * HALF + m * 16) * ldc + col0;
                const f32x4 a0 = acc[ai][0][m][0], a1 = acc[ai][0][m][1], b0 = acc[ai][1][m][0], b1 = acc[ai][1][m][1];
                f32x4 h0, h1;
#pragma unroll
                for (int j = 0; j < 4; ++j) { h0[j] = silu_fast(a0[j]) * b0[j]; h1[j] = silu_fast(a1[j]) * b1[j]; }
                u32x4 w; w.x = cvt_pk_bf16(h0[0], h0[1]); w.y = cvt_pk_bf16(h0[2], h0[3]); w.z = cvt_pk_bf16(h1[0], h1[1]); w.w = cvt_pk_bf16(h1[2], h1[3]);
                *(u32x4*)rowp = w;
            }
    }
};
struct EpiResid {
    static constexpr bool PERM = false, AFTER_DRAIN = false;
    float* xlat; float* xctx; const float* gate; float coef;
    __device__ __forceinline__ void operator()(const f32x4 (&acc)[2][2][4][2], const Unit& u, int wr, int wc, int fr, int fq) const {
        const int row0 = u.pm * BM + wr * 64 + fr, col0 = u.pn * BM + wc * 32 + 4 * fq;
        const int mr = (u.pm < 64) ? (u.pm >> 4) : 4;
        const float* gr = gate + (size_t)mr * NMODC + col0;
        float* xb = (u.pm < 64 ? xlat + (size_t)row0 * D : xctx + (size_t)(row0 - TL) * D) + col0;
#pragma unroll
        for (int bj = 0; bj < 2; ++bj)
#pragma unroll
            for (int n = 0; n < 2; ++n) {
                const f32x4 gv = *(const f32x4*)(gr + bj * HALF + n * 16) * coef;
#pragma unroll
                for (int ai = 0; ai < 2; ++ai)
#pragma unroll
                    for (int m = 0; m < 4; ++m) { float* q = xb + (size_t)(ai * HALF + m * 16) * D + bj * HALF + n * 16; f32x4 xv = *(const f32x4*)q; xv += gv * acc[ai][bj][m][n]; *(f32x4*)q = xv; }
                asm volatile("" ::: "memory");
            }
    }
};
struct EpiStoreF32 {
    static constexpr bool PERM = false, AFTER_DRAIN = false;
    float* C; int ldc;
    __device__ __forceinline__ void operator()(const f32x4 (&acc)[2][2][4][2], const Unit& u, int wr, int wc, int fr, int fq) const {
        const int row0 = u.pm * BM + wr * 64 + fr, col0 = u.pn * BM + wc * 32 + 4 * fq;
#pragma unroll
        for (int ai = 0; ai < 2; ++ai)
#pragma unroll
            for (int m = 0; m < 4; ++m) { float* rowp = C + (size_t)(row0 + ai * HALF + m * 16) * ldc + col0;
#pragma unroll
                for (int bj = 0; bj < 2; ++bj)
#pragma unroll
                    for (int n = 0; n < 2; ++n) *(f32x4*)(rowp + bj * HALF + n * 16) = acc[ai][bj][m][n]; }
    }
};
template <class Epi, class Sched, bool STAMP = false>
__device__ __forceinline__ void gemm_phase(PG8_LAS unsigned char* lds, const Gemm g, const Sched& S, const Epi& E, unsigned long long* stamps) {
    int tid_raw = threadIdx.x; asm volatile("" : "+v"(tid_raw)); const int tid = tid_raw, wid = __builtin_amdgcn_readfirstlane(tid >> 6), lane = tid & 63, wr = wid >> 2, wc = wid & 3, fr = lane & 15, fq = lane >> 4;
    const int K = g.K, nt = K / BK;
    int ts_lo = 0, ts_hi = 0, nts = 0; const unsigned long long rt_entry = STAMP ? (unsigned long long)wall_clock64() : 0ull;
#define PG8_STAMP() do { if (STAMP && wid == 0 && nts < 64) { const unsigned long long _c = (unsigned long long)clock64(); \
        ts_lo = (lane == nts) ? (int)(unsigned)_c : ts_lo; ts_hi = (lane == nts) ? (int)(unsigned)(_c >> 32) : ts_hi; ++nts; } } while (0)
    PG8_STAMP();
    unsigned voffA[2], voffB[2];
#pragma unroll
    for (int i = 0; i < 2; ++i) { int R, C; stage_rc(tid * 16 + i * 8192, R, C); const int Rb = Epi::PERM ? ((R & ~31) + perm32(R & 31)) : R;
        voffA[i] = (unsigned)(R * K + C) * 2u; voffB[i] = (unsigned)(Rb * K + C) * 2u; }
    const size_t kstep = (size_t)(BK * 2);
    const size_t hstep = (size_t)HALF * K * 2;
    const size_t tstep = 2 * hstep;
    const unsigned ldsw = (unsigned)wid * 1024u;
    const int aoff = lds_byte(wr * 64 + fr, fq * 8), boff = lds_byte(wc * 32 + fr, fq * 8);
#define PG8_SA(b, h) (((b) * 2 + (h)) * HTB)
#define PG8_SB(b, h) ((4 + (b) * 2 + (h)) * HTB)
#define PG8_STAGE(bufoff, gbase, voff) do { _Pragma("unroll") for (int _i = 0; _i < 2; ++_i) \
        __builtin_amdgcn_global_load_lds((const unsigned*)((const char*)(gbase) + (voff)[_i]), (PG8_LAS unsigned*)(lds + (bufoff) + ldsw + _i * 8192), 16, 0, 0); } while (0)
#define PG8_LDA(dst, b, h) do { _Pragma("unroll") for (int m = 0; m < 4; ++m) _Pragma("unroll") for (int k = 0; k < 2; ++k) dst[m][k] = *(const PG8_LAS bf16x8*)(lds + PG8_SA(b, h) + aoff + m * 2048 + k * 1024); } while (0)
#define PG8_LDB(dst, b, h) do { _Pragma("unroll") for (int n = 0; n < 2; ++n) _Pragma("unroll") for (int k = 0; k < 2; ++k) dst[n][k] = *(const PG8_LAS bf16x8*)(lds + PG8_SB(b, h) + boff + n * 2048 + k * 1024); } while (0)
#define PG8_MMA(ai, bj, At, Bt) do { __builtin_amdgcn_s_setprio(1); _Pragma("unroll") for (int m = 0; m < 4; ++m) _Pragma("unroll") for (int n = 0; n < 2; ++n) _Pragma("unroll") for (int k = 0; k < 2; ++k) \
        acc[ai][bj][m][n] = __builtin_amdgcn_mfma_f32_16x16x32_bf16(Bt[n][k], At[m][k], acc[ai][bj][m][n], 0, 0, 0); __builtin_amdgcn_s_setprio(0); } while (0)
#define PG8_WAIT_V(n) asm volatile("s_waitcnt vmcnt(" #n ")" ::: "memory")
#define PG8_WAIT_L(n) asm volatile("s_waitcnt lgkmcnt(" #n ")" ::: "memory")
#define PG8_BAR __builtin_amdgcn_s_barrier()
#define PG8_SCHED __builtin_amdgcn_sched_barrier(0)
    Unit cur, nxt; int ui = 0;
    if (!S.next(0, cur)) return;
    f32x4 acc[2][2][4][2];
#pragma unroll
    for (int a = 0; a < 2; ++a)
#pragma unroll
        for (int b = 0; b < 2; ++b)
#pragma unroll
            for (int m = 0; m < 4; ++m)
#pragma unroll
                for (int n = 0; n < 2; ++n) acc[a][b][m][n] = (f32x4){0.f, 0.f, 0.f, 0.f};
    bf16x8 At[4][2], B0[2][2], B1[2][2];
    const char* cA = (const char*)g.A + (size_t)cur.pm * tstep; const char* cB = (const char*)g.Bt + (size_t)cur.pn * tstep;
    S.a_ready(cur);
    PG8_STAGE(PG8_SB(0, 0), cB, voffB); PG8_STAGE(PG8_SA(0, 0), cA, voffA); PG8_STAGE(PG8_SB(0, 1), cB + hstep, voffB); PG8_STAGE(PG8_SA(0, 1), cA + hstep, voffA);
    if (wr == 1) PG8_BAR;
    PG8_WAIT_V(4); PG8_BAR;
    PG8_STAGE(PG8_SB(1, 0), cB + kstep, voffB); PG8_STAGE(PG8_SA(1, 0), cA + kstep, voffA); PG8_STAGE(PG8_SB(1, 1), cB + hstep + kstep, voffB);
    PG8_WAIT_V(6); PG8_BAR;
    PG8_STAMP();
    for (;;) {
        const bool has_next = S.next(ui + 1, nxt);
        const char* nA = has_next ? (const char*)g.A + (size_t)nxt.pm * tstep : cA; const char* nB = has_next ? (const char*)g.Bt + (size_t)nxt.pn * tstep : cB;
        for (int t = 0; t < nt; t += 2) {
            const bool last = (t == nt - 2);
            const char* a1 = cA + (size_t)(t + 1) * kstep;
            const char* a2 = last ? nA : cA + (size_t)(t + 2) * kstep; const char* b2 = last ? nB : cB + (size_t)(t + 2) * kstep;
            const char* a3 = a2 + kstep; const char* b3 = b2 + kstep;
            if (last && has_next) S.a_ready(nxt);
            PG8_LDB(B0, 0, 0); PG8_SCHED; PG8_LDA(At, 0, 0); PG8_STAGE(PG8_SA(1, 1), a1 + hstep, voffA);
            PG8_WAIT_L(8); PG8_BAR; PG8_WAIT_L(0); PG8_MMA(0, 0, At, B0); PG8_BAR; PG8_SCHED;
            PG8_LDB(B1, 0, 1); PG8_STAGE(PG8_SB(0, 0), b2, voffB);
            PG8_BAR; PG8_WAIT_L(0); PG8_MMA(0, 1, At, B1); PG8_BAR;
            PG8_LDA(At, 0, 1); PG8_STAGE(PG8_SA(0, 0), a2, voffA);
            PG8_BAR; PG8_WAIT_L(0); PG8_MMA(1, 0, At, B0); PG8_BAR; PG8_SCHED;
            PG8_STAGE(PG8_SB(0, 1), b2 + hstep, voffB);
            PG8_WAIT_V(6); PG8_BAR; PG8_MMA(1, 1, At, B1); PG8_BAR;
            PG8_LDB(B0, 1, 0); PG8_SCHED; PG8_LDA(At, 1, 0); PG8_STAGE(PG8_SA(0, 1), a2 + hstep, voffA);
            PG8_WAIT_L(8); PG8_BAR; PG8_WAIT_L(0); PG8_MMA(0, 0, At, B0); PG8_BAR; PG8_SCHED;
            PG8_LDB(B1, 1, 1); PG8_STAGE(PG8_SB(1, 0), b3, voffB);
            PG8_BAR; PG8_WAIT_L(0); PG8_MMA(0, 1, At, B1); PG8_BAR;
            PG8_LDA(At, 1, 1); PG8_STAGE(PG8_SA(1, 0), a3, voffA);
            PG8_BAR; PG8_WAIT_L(0); PG8_MMA(1, 0, At, B0); PG8_BAR; PG8_SCHED;
            PG8_STAGE(PG8_SB(1, 1), b3 + hstep, voffB);
            PG8_WAIT_V(6); PG8_BAR; PG8_MMA(1, 1, At, B1); PG8_BAR;
        }
        PG8_STAMP();
        if constexpr (!Epi::AFTER_DRAIN) { E(acc, cur, wr, wc, fr, fq); S.done(cur); }
        PG8_STAMP();
        if (!has_next) break;
#pragma unroll
        for (int a = 0; a < 2; ++a)
#pragma unroll
            for (int b = 0; b < 2; ++b)
#pragma unroll
                for (int m = 0; m < 4; ++m)
#pragma unroll
                    for (int n = 0; n < 2; ++n) acc[a][b][m][n] = (f32x4){0.f, 0.f, 0.f, 0.f};
        cur = nxt; cA = nA; cB = nB; ++ui;
    }
    PG8_WAIT_V(0);
    if (wr == 0) PG8_BAR;
    PG8_BAR;
    if constexpr (Epi::AFTER_DRAIN) { E.fused(acc, cur, wr, wc, fr, fq, lds, wid, lane); S.done(cur); }
    PG8_STAMP();
    if (STAMP && wid == 0) { stamps[lane] = lane < nts ? (((unsigned long long)(unsigned)ts_hi << 32) | (unsigned)ts_lo) : 0ull;
        if (lane == 62) stamps[62] = rt_entry; if (lane == 63) stamps[63] = (unsigned long long)wall_clock64(); }
#undef PG8_STAMP
#undef PG8_SA
#undef PG8_SB
#undef PG8_STAGE
#undef PG8_LDA
#undef PG8_LDB
#undef PG8_MMA
#undef PG8_WAIT_V
#undef PG8_WAIT_L
#undef PG8_BAR
#undef PG8_SCHED
}
}
#define LAS __attribute__((address_space(3)))
typedef unsigned short bf16_t;
using pg8::f32x4; using pg8::u32x4; using pg8::bf16x8; using pg8::cvt_pk_bf16;
typedef float f32x2 __attribute__((ext_vector_type(2)));
typedef unsigned u32x2 __attribute__((ext_vector_type(2)));
#define LDS_WAIT() asm volatile("s_waitcnt lgkmcnt(0)" ::: "memory")

enum { I_X = 0, I_C, I_CTX, I_CCTX, I_NORMG, I_WMOD, I_BMOD, I_FFNIN, I_FFNOUT, I_WIN, I_WOUT, I_GLA_WDEC, I_GLA_BDEC, I_GLA_NORM,
       I_SSM_CONVW, I_SSM_CONVB, I_SSM_DTB, I_SSM_ALOG, I_SSM_D, I_SSM_NORM, I_RW_MU, I_RW_W0, I_RW_WDEC, I_RW_A0, I_RW_WA, I_RW_WG,
       I_RW_KK, I_RW_KA, I_RW_RK, I_RW_LNG, I_RW_LNB, I_ATT_QN, I_ATT_KN, N_INPUTS };
struct Params { const float* in[N_INPUTS]; float* out; unsigned char* ws; int ph_lo, ph_hi; };

constexpr size_t al256(size_t x) { return (x + 255) & ~(size_t)255; }
constexpr size_t WS_WUP = 0;
constexpr size_t WS_WDN = WS_WUP + al256((size_t)2 * NUP * D * 2);
constexpr size_t WS_WIN = WS_WDN + al256((size_t)2 * D * DFF * 2);
constexpr size_t WS_WOUT = WS_WIN + al256((size_t)NINP * D * 2);
constexpr size_t WS_MOD = WS_WOUT + al256((size_t)D * D * 2);
constexpr size_t WS_XCTX = WS_MOD + al256((size_t)DEPTH * 5 * NMODC * 4);
constexpr size_t WS_HID = WS_XCTX + al256((size_t)TC * D * 4);
constexpr size_t WS_HA = WS_HID + al256((size_t)T * DFF * 2);
constexpr size_t WS_RW = WS_HID;
constexpr size_t WS_U = WS_HA + al256((size_t)T * D * 2);
constexpr size_t WS_G = WS_U + al256((size_t)T * NINP * 4);
constexpr size_t WS_DEC = WS_G + al256((size_t)T * 256 * 4);
constexpr size_t WS_XBC = WS_DEC + al256((size_t)T * 256 * 4);
constexpr size_t WS_DT = WS_XBC + al256((size_t)T * 512 * 4);
constexpr size_t WS_ATTQ = WS_DT + al256((size_t)T * 16 * 4);
constexpr size_t WS_ATTK = WS_ATTQ + al256((size_t)T * 256 * 2);
constexpr size_t WS_ATTVT = WS_ATTK + al256((size_t)T * 128 * 2);
constexpr size_t WS_Y = WS_ATTVT + al256((size_t)T * 128 * 2);
constexpr size_t WS_CAT = WS_Y + al256((size_t)3 * T * 256 * 4);
constexpr size_t WS_END = WS_CAT + al256((size_t)T * D * 2);
static_assert((size_t)T * 4 * 7 * 64 * 4 <= (WS_U - WS_HID), "RWKV streams must fit the hid|hA region");
constexpr int LDS_BYTES = 131072 + 1024;
constexpr int NKEY = SEQ + CTXL;

struct Frame { LAS unsigned char* lds; int tid, lane, wave, bid, nblk; };

__device__ __forceinline__ float wave_sum(float v) {
#pragma unroll
    for (int o = 1; o < 64; o <<= 1) v += __shfl_xor(v, o);
    return v;
}
__device__ __forceinline__ float sum16(float v) { v += __shfl_xor(v, 1); v += __shfl_xor(v, 2); v += __shfl_xor(v, 4); v += __shfl_xor(v, 8); return v; }
__device__ __forceinline__ float sigmoid_f(float x) { return 1.0f / (1.0f + expf(-x)); }
__device__ __forceinline__ float silu_f(float x) { return x * sigmoid_f(x); }
__device__ __forceinline__ float softplus_f(float x) { return fmaxf(x, 0.f) + log1pf(expf(-fabsf(x))); }
__device__ __forceinline__ int modrow_of(int r) { return r < TL ? (r >> 12) : 4; }
__device__ __forceinline__ void seq_of(int r, int& pos, int& len) { if (r < TL) { pos = r & (SEQ - 1); len = SEQ; } else { pos = (r - TL) & (CTXL - 1); len = CTXL; } }
__device__ __forceinline__ float* xrow_of(const Params& p, int r) { return r < TL ? p.out + (size_t)r * D : (float*)(p.ws + WS_XCTX) + (size_t)(r - TL) * D; }

__device__ __forceinline__ void conv_item(const float* __restrict__ W, int ldw, int srclimit, int srccol0, int k0, bf16_t* dst, int K, LAS float* scr, int lane) {
#pragma unroll 8
    for (int i = 0; i < 32; ++i) { const int kk = 2 * i + (lane >> 5), j = lane & 31, sc = srccol0 + j; scr[kk * 33 + j] = sc < srclimit ? W[(size_t)(k0 + kk) * ldw + sc] : 0.f; }
    LDS_WAIT();
    const int c = lane & 7;
#pragma unroll
    for (int jj = 0; jj < 4; ++jj) { const int n = (lane >> 3) + 8 * jj; const LAS float* s = scr + (8 * c) * 33 + n;
        u32x4 o; o.x = cvt_pk_bf16(s[0], s[33]); o.y = cvt_pk_bf16(s[66], s[99]); o.z = cvt_pk_bf16(s[132], s[165]); o.w = cvt_pk_bf16(s[198], s[231]);
        *(u32x4*)(dst + (size_t)n * K + k0 + 8 * c) = o; }
    LDS_WAIT();
}
__device__ __forceinline__ void phase_conv(const Params& p, const Frame& F, int l) {
    LAS float* scr = (LAS float*)(F.lds + F.wave * 8448);
    bf16_t* wup = (bf16_t*)(p.ws + WS_WUP); bf16_t* wdn = (bf16_t*)(p.ws + WS_WDN); bf16_t* win = (bf16_t*)(p.ws + WS_WIN); bf16_t* wout = (bf16_t*)(p.ws + WS_WOUT);
    constexpr int I_UP = 16 * 176, I_DN = 44 * 32, I_INW = 16 * 104, I_OUTW = 16 * 32, NITEMS = 2 * I_UP + 2 * I_DN + I_INW + I_OUTW;
    const int gw = F.bid * 8 + F.wave, NGW = F.nblk * 8;
    for (int it = gw; it < NITEMS; it += NGW) {
        int r = it;
        if (r < 2 * I_UP) { const int f = r / I_UP; r -= f * I_UP; const int kb = r / 176, nb = r % 176, n0 = 32 * nb, pn = n0 >> 8, bj = (n0 >> 7) & 1, j0 = n0 & 127;
            conv_item(p.in[I_FFNIN] + (size_t)(l * 2 + f) * D * NUP, NUP, NUP, bj * DFF + 128 * pn + j0, 64 * kb, wup + (size_t)f * NUP * D + (size_t)n0 * D, D, scr, F.lane); continue; }
        r -= 2 * I_UP;
        if (r < 2 * I_DN) { const int f = r / I_DN; r -= f * I_DN; const int kb = r / 32, nb = r % 32, n0 = 32 * nb;
            conv_item(p.in[I_FFNOUT] + (size_t)(l * 2 + f) * DFF * D, D, D, n0, 64 * kb, wdn + (size_t)f * D * DFF + (size_t)n0 * DFF, DFF, scr, F.lane); continue; }
        r -= 2 * I_DN;
        if (r < I_INW) { const int kb = r / 104, nb = r % 104, n0 = 32 * nb;
            conv_item(p.in[I_WIN] + (size_t)l * D * NIN, NIN, NIN, n0, 64 * kb, win + (size_t)n0 * D, D, scr, F.lane); continue; }
        r -= I_INW;
        { const int kb = r / 32, nb = r % 32, n0 = 32 * nb;
            conv_item(p.in[I_WOUT] + (size_t)l * D * D, D, D, n0, 64 * kb, wout + (size_t)n0 * D, D, scr, F.lane); }
    }
}
__device__ __forceinline__ void phase_mod_init(const Params& p, const Frame& F) {
    LAS float* sc = (LAS float*)F.lds; LAS float* part = sc + 5 * D;
    for (int i = F.tid; i < 5 * D; i += 512) { const int r = i >> 10, k = i & 1023; const float cv = r < 4 ? p.in[I_C][r * D + k] : p.in[I_CCTX][k]; sc[i] = silu_f(cv); }
    __syncthreads();
    float* mod = (float*)(p.ws + WS_MOD);
    for (int item = F.bid; item < DEPTH * 144; item += F.nblk) {
        const int l = item / 144, cb = item % 144;
        const float* W = p.in[I_WMOD] + (size_t)l * D * NMODC + cb * 64 + F.lane;
        float a0 = 0.f, a1 = 0.f, a2 = 0.f, a3 = 0.f, a4 = 0.f;
#pragma unroll 8
        for (int k = F.wave * 128; k < F.wave * 128 + 128; ++k) { const float w = W[(size_t)k * NMODC]; a0 += sc[k] * w; a1 += sc[D + k] * w; a2 += sc[2 * D + k] * w; a3 += sc[3 * D + k] * w; a4 += sc[4 * D + k] * w; }
        part[(F.wave * 5 + 0) * 64 + F.lane] = a0; part[(F.wave * 5 + 1) * 64 + F.lane] = a1; part[(F.wave * 5 + 2) * 64 + F.lane] = a2; part[(F.wave * 5 + 3) * 64 + F.lane] = a3; part[(F.wave * 5 + 4) * 64 + F.lane] = a4;
        __syncthreads();
        if (F.tid < 320) { const int r = F.tid >> 6, ln = F.tid & 63; float s = p.in[I_BMOD][l * NMODC + cb * 64 + ln];
#pragma unroll
            for (int w = 0; w < 8; ++w) s += part[(w * 5 + r) * 64 + ln];
            mod[(size_t)(l * 5 + r) * NMODC + cb * 64 + ln] = s; }
        __syncthreads();
    }
    const f32x4* xs = (const f32x4*)p.in[I_X]; f32x4* xd = (f32x4*)p.out;
    for (size_t i = (size_t)F.bid * 512 + F.tid; i < (size_t)TL * D / 4; i += (size_t)F.nblk * 512) xd[i] = xs[i];
    const f32x4* cs = (const f32x4*)p.in[I_CTX]; f32x4* cd = (f32x4*)(p.ws + WS_XCTX);
    for (size_t i = (size_t)F.bid * 512 + F.tid; i < (size_t)TC * D / 4; i += (size_t)F.nblk * 512) cd[i] = cs[i];
}
__device__ __forceinline__ void phase_normmod(const Params& p, const Frame& F, int l, int which) {
    const float* mod = (const float*)(p.ws + WS_MOD) + (size_t)(l * 5) * NMODC + (3 * which) * D;
    const float* g = p.in[I_NORMG] + (size_t)(l * 3 + which) * D;
    bf16_t* hA = (bf16_t*)(p.ws + WS_HA);
    f32x4 gv[4];
#pragma unroll
    for (int j = 0; j < 4; ++j) gv[j] = *(const f32x4*)(g + 4 * F.lane + 256 * j);
    for (int r = F.bid * 8 + F.wave; r < T; r += F.nblk * 8) {
        const float* xr = xrow_of(p, r); const float* sh = mod + (size_t)modrow_of(r) * NMODC; const float* scl = sh + D;
        f32x4 v[4]; float ss = 0.f;
#pragma unroll
        for (int j = 0; j < 4; ++j) { v[j] = *(const f32x4*)(xr + 4 * F.lane + 256 * j); ss += (v[j].x * v[j].x + v[j].y * v[j].y) + (v[j].z * v[j].z + v[j].w * v[j].w); }
        const float rstd = 1.0f / sqrtf(wave_sum(ss) * (1.0f / D) + 1e-6f);
#pragma unroll
        for (int j = 0; j < 4; ++j) { const f32x4 s4 = *(const f32x4*)(scl + 4 * F.lane + 256 * j), h4 = *(const f32x4*)(sh + 4 * F.lane + 256 * j);
            const f32x4 o = v[j] * rstd * gv[j] * (s4 + 1.0f) + h4;
            u32x2 w; w.x = cvt_pk_bf16(o.x, o.y); w.y = cvt_pk_bf16(o.z, o.w);
            *(u32x2*)(hA + (size_t)r * D + 4 * F.lane + 256 * j) = w; }
    }
}
constexpr int U_GLA_Q = 0, U_GLA_K = 128, U_GLA_V = 256, U_GLA_G = 512, U_GLA_LR = 768;
constexpr int U_SSM_Z = 784, U_SSM_XBC = 1040, U_SSM_DT = 1552;
constexpr int U_RW = 1556;
constexpr int U_ATT_Q = 2580, U_ATT_K = 2836, U_ATT_V = 2964;

__device__ __forceinline__ void phase_prep(const Params& p, const Frame& F, int l) {
    const float* U = (const float*)(p.ws + WS_U);
    const size_t gtid = (size_t)F.bid * 512 + F.tid, gstride = (size_t)F.nblk * 512;
    { f32x4* y = (f32x4*)(p.ws + WS_Y); const f32x4 z = {0.f, 0.f, 0.f, 0.f};
      for (size_t i = gtid; i < (size_t)3 * T * 256 / 4; i += gstride) y[i] = z; }
    { float* dec = (float*)(p.ws + WS_DEC); const float* wdec = p.in[I_GLA_WDEC] + (size_t)l * 2 * 16 * 128; const float* bdec = p.in[I_GLA_BDEC] + (size_t)l * 2 * 128;
      for (size_t i = gtid; i < (size_t)T * 256; i += gstride) { const int t = (int)(i >> 8), dc = (int)(i & 255), d = dc >> 7, c = dc & 127;
          const float* lr = U + (size_t)t * NINP + U_GLA_LR; float z = bdec[d * 128 + c];
#pragma unroll
          for (int k = 0; k < 16; ++k) z += lr[k] * wdec[(d * 16 + k) * 128 + c];
          dec[i] = expf(-softplus_f(-z) * (1.0f / 16.0f)); } }
    { float* xbc = (float*)(p.ws + WS_XBC); const float* cw = p.in[I_SSM_CONVW] + (size_t)l * 3 * 512; const float* cb = p.in[I_SSM_CONVB] + (size_t)l * 512;
      for (size_t i = gtid; i < (size_t)T * 512; i += gstride) { const int t = (int)(i >> 9), ch = (int)(i & 511); int pos, len; seq_of(t, pos, len);
          const float* ur = U + (size_t)t * NINP + U_SSM_XBC + ch; float a = cb[ch] + cw[512 + ch] * ur[0];
          if (pos > 0) a += cw[ch] * ur[-NINP];
          if (pos < len - 1) a += cw[1024 + ch] * ur[NINP];
          xbc[i] = silu_f(a); }
      float* dtb = (float*)(p.ws + WS_DT); const float* bias = p.in[I_SSM_DTB] + l * 8; const float* alog = p.in[I_SSM_ALOG] + l * 8;
      for (size_t i = gtid; i < (size_t)T * 8; i += gstride) { const int t = (int)(i >> 3), dh = (int)(i & 7), h = dh & 3;
          const float dtv = softplus_f(U[(size_t)t * NINP + U_SSM_DT + h] + bias[dh]);
          dtb[(size_t)t * 16 + dh] = dtv; dtb[(size_t)t * 16 + 8 + dh] = expf(-dtv * expf(alog[dh])); } }
    { bf16_t* aq = (bf16_t*)(p.ws + WS_ATTQ); bf16_t* ak = (bf16_t*)(p.ws + WS_ATTK); bf16_t* avt = (bf16_t*)(p.ws + WS_ATTVT);
      const float qn = p.in[I_ATT_QN][l * 64 + F.lane], kn = p.in[I_ATT_KN][l * 64 + F.lane];
      const int dd = F.lane, axis = dd >> 5, half = (dd >> 4) & 1, fi = dd & 15;
      const float inv = exp2f(-(float)fi * 0.8304820237218406f);
      for (int t = F.bid * 8 + F.wave; t < T; t += F.nblk * 8) {
          const float* ur = U + (size_t)t * NINP; const bool lat = t < TL; int pos, len; seq_of(t, pos, len);
          const int b = lat ? (t >> 12) : ((t - TL) >> 8); const int key = lat ? pos : SEQ + pos;
          float cs = 1.f, sn = 0.f;
          if (lat) { const float ang = (float)(axis == 0 ? (pos >> 6) : (pos & 63)) * inv; const float kq = rintf(ang * 0.15915494309189535f);
              float rr = fmaf(-kq, 6.28125f, ang); rr = fmaf(-kq, 1.9353071795864769e-3f, rr); cs = cosf(rr); sn = sinf(rr); }
#pragma unroll
          for (int hh = 0; hh < 6; ++hh) {
              const float v = ur[(hh < 4 ? U_ATT_Q + hh * 64 : U_ATT_K + (hh - 4) * 64) + dd];
              const float ss = wave_sum(v * v); float n = v * (1.0f / sqrtf(ss * (1.0f / 64.0f) + 1e-6f)) * (hh < 4 ? qn : kn);
              const float pr = __shfl_xor(n, 16);
              n = n * cs + (half ? pr * sn : -pr * sn);
              if (hh < 4) { aq[(size_t)t * 256 + hh * 64 + dd] = (bf16_t)(cvt_pk_bf16(n * 0.18033688011112042f, 0.f) & 0xffffu); }
              else { ak[((size_t)(b * 2 + (hh - 4)) * NKEY + key) * 64 + dd] = (bf16_t)(cvt_pk_bf16(n, 0.f) & 0xffffu); }
          }
#pragma unroll
          for (int hh = 0; hh < 2; ++hh) { const float v = ur[U_ATT_V + hh * 64 + dd]; avt[((size_t)(b * 2 + hh) * 64 + dd) * NKEY + key] = (bf16_t)(cvt_pk_bf16(v, 0.f) & 0xffffu); }
      } }
    { LAS float* sh = (LAS float*)F.lds;
      float* S = (float*)(p.ws + WS_RW); float* G = (float*)(p.ws + WS_G);
      const float* mu0 = p.in[I_RW_MU] + (size_t)l * 2 * 1024; const float* mu1 = mu0 + 1024;
      const float* w0 = p.in[I_RW_W0] + (size_t)l * 2 * 256; const float* wdec = p.in[I_RW_WDEC] + (size_t)l * 2 * 64 * 256;
      const float* wa = p.in[I_RW_WA] + (size_t)l * 64 * 256; const float* wg = p.in[I_RW_WG] + (size_t)l * 128 * 256;
      const int c = F.tid & 255, tg = F.tid >> 8, h = c >> 6;
      const float a0c = p.in[I_RW_A0][l * 256 + c], kkc = p.in[I_RW_KK][l * 256 + c], kac = p.in[I_RW_KA][l * 256 + c], w00 = w0[c], w01 = w0[256 + c];
      __syncthreads();
      for (int tile = F.bid; tile < T / 16; tile += F.nblk) {
          const int r0 = tile * 16;
          for (int idx = F.tid; idx < 16 * 1024; idx += 512) { const int tt = idx >> 10, ci = idx & 1023, r = r0 + tt; int pos, len; seq_of(r, pos, len);
              const float* ur = U + (size_t)r * NINP + U_RW + ci; const float cur = ur[0];
              const float prev = pos > 0 ? ur[-NINP] : 0.f, next = pos < len - 1 ? ur[NINP] : 0.f;
              float val = cur + mu0[ci] * (prev - cur) + mu1[ci] * (next - cur);
              if (ci >= 768 && ci < 832) val = tanhf(val); else if (ci >= 896) val = sigmoid_f(val);
              sh[idx] = val; }
          __syncthreads();
          float aa[8], ag[8], aw0[8], aw1[8];
#pragma unroll
          for (int t8 = 0; t8 < 8; ++t8) { aa[t8] = 0.f; ag[t8] = 0.f; aw0[t8] = 0.f; aw1[t8] = 0.f; }
          const LAS float* shb = sh + (tg * 8) * 1024;
          for (int i = 0; i < 64; i += 4) {
              float wav[4], wd0[4], wd1[4];
#pragma unroll
              for (int e = 0; e < 4; ++e) { wav[e] = wa[(i + e) * 256 + c]; wd0[e] = wdec[(i + e) * 256 + c]; wd1[e] = wdec[(64 + i + e) * 256 + c]; }
#pragma unroll
              for (int t8 = 0; t8 < 8; ++t8) { const f32x4 la = *(const LAS f32x4*)(shb + t8 * 1024 + 832 + i), lw = *(const LAS f32x4*)(shb + t8 * 1024 + 768 + i);
#pragma unroll
                  for (int e = 0; e < 4; ++e) { aa[t8] += la[e] * wav[e]; aw0[t8] += lw[e] * wd0[e]; aw1[t8] += lw[e] * wd1[e]; } }
          }
          for (int i = 0; i < 128; i += 4) {
              float wgv[4];
#pragma unroll
              for (int e = 0; e < 4; ++e) wgv[e] = wg[(i + e) * 256 + c];
#pragma unroll
              for (int t8 = 0; t8 < 8; ++t8) { const f32x4 lg = *(const LAS f32x4*)(shb + t8 * 1024 + 896 + i);
#pragma unroll
                  for (int e = 0; e < 4; ++e) ag[t8] += lg[e] * wgv[e]; }
          }
#pragma unroll
          for (int t8 = 0; t8 < 8; ++t8) {
              const int r = r0 + tg * 8 + t8; const LAS float* st = shb + t8 * 1024;
              const float a = sigmoid_f(a0c + aa[t8]); const float kraw = st[256 + c], rr = st[c], vv = st[512 + c];
              const float kkr = kraw * kkc; const float ss = wave_sum(kkr * kkr); const float kk = kkr / fmaxf(sqrtf(ss), 1e-12f);
              const float k2 = kraw * (1.0f + (a - 1.0f) * kac);
              const float wv0 = expf(-expf(-softplus_f(-(w00 + aw0[t8])) - 0.5f)), wv1 = expf(-expf(-softplus_f(-(w01 + aw1[t8])) - 0.5f));
              float* sp = S + ((size_t)r * 4 + h) * 448 + (c & 63);
              sp[0] = rr; sp[64] = wv0; sp[128] = wv1; sp[192] = k2; sp[256] = -kk; sp[320] = kk * a; sp[384] = vv;
              G[(size_t)r * 256 + c] = ag[t8];
          }
          __syncthreads();
      } }
}
__device__ __forceinline__ int chain_row(int b, int dir, int n) { return n < CTXL ? (TL + b * CTXL + (dir ? CTXL - 1 - n : n)) : (b * SEQ + (dir ? SEQ - 1 - (n - CTXL) : (n - CTXL))); }

__device__ __forceinline__ void rwkv_scan_direct(const Params& p, int b, int h, int dir, int lane) {
    const float* S = (const float*)(p.ws + WS_RW); float* Y = (float*)(p.ws + WS_Y) + (size_t)2 * T * 256;
    float s[64];
#pragma unroll
    for (int j = 0; j < 64; ++j) s[j] = 0.f;
    for (int n = 0; n < NKEY; ++n) {
        const int r = chain_row(b, dir, n);
        const float* base = S + ((size_t)r * 4 + h) * 448;
        const float* pr = base; const float* pw = base + 64 * (1 + dir); const float* pk = base + 192; const float* pa = base + 256; const float* pb = base + 320;
        const float v = base[384 + lane];
        float sa = 0.f;
#pragma unroll
        for (int j = 0; j < 64; ++j) sa += s[j] * pa[j];
        float y = 0.f;
#pragma unroll
        for (int j = 0; j < 64; ++j) { s[j] = s[j] * pw[j] + sa * pb[j] + v * pk[j]; y += s[j] * pr[j]; }
        unsafeAtomicAdd(Y + (size_t)r * 256 + h * 64 + lane, y);
    }
}
__device__ __forceinline__ void gla_scan_direct(const Params& p, int b, int h, int dir, int lane) {
    const float* U = (const float*)(p.ws + WS_U); const float* DEC = (const float*)(p.ws + WS_DEC); float* Y = (float*)(p.ws + WS_Y);
    float s[32];
#pragma unroll
    for (int j = 0; j < 32; ++j) s[j] = 0.f;
    for (int n = 0; n < NKEY; ++n) {
        const int r = chain_row(b, dir, n);
        const float* ur = U + (size_t)r * NINP; const float* q = ur + U_GLA_Q + h * 32; const float* k = ur + U_GLA_K + h * 32; const float* a = DEC + (size_t)r * 256 + dir * 128 + h * 32;
        const float v = ur[U_GLA_V + h * 64 + lane];
        float o = 0.f;
#pragma unroll
        for (int j = 0; j < 32; ++j) { s[j] = a[j] * s[j] + k[j] * v; o += q[j] * s[j]; }
        unsafeAtomicAdd(Y + (size_t)r * 256 + h * 64 + lane, o * 0.17677669529663687f);
    }
}
__device__ __forceinline__ void ssd_scan_direct(const Params& p, int b, int h, int dir, int lane) {
    const float* XBC = (const float*)(p.ws + WS_XBC); const float* DT = (const float*)(p.ws + WS_DT); float* Y = (float*)(p.ws + WS_Y) + (size_t)T * 256;
    const int g = h >> 1;
    float s[64];
#pragma unroll
    for (int j = 0; j < 64; ++j) s[j] = 0.f;
    for (int n = 0; n < NKEY; ++n) {
        const int r = chain_row(b, dir, n);
        const float* xb = XBC + (size_t)r * 512; const float* B = xb + 256 + g * 64; const float* C = xb + 384 + g * 64;
        const float dt = DT[(size_t)r * 16 + dir * 4 + h], dA = DT[(size_t)r * 16 + 8 + dir * 4 + h];
        const float xdt = xb[h * 64 + lane] * dt;
        float y = 0.f;
#pragma unroll
        for (int j = 0; j < 64; ++j) { s[j] = dA * s[j] + xdt * B[j]; y += C[j] * s[j]; }
        unsafeAtomicAdd(Y + (size_t)r * 256 + h * 64 + lane, y);
    }
}
__device__ __forceinline__ void att_item(const Params& p, const Frame& F, int item) {
    const bool isctx = item >= 512; int b, hkv, qb;
    if (!isctx) { b = item >> 7; hkv = (item >> 6) & 1; qb = item & 63; } else { const int i2 = item - 512; b = i2 >> 3; hkv = (i2 >> 2) & 1; qb = i2 & 3; }
    const int kt0 = isctx ? 64 : 0, kt1 = 68;
    const bf16_t* Kg = (const bf16_t*)(p.ws + WS_ATTK) + (size_t)(b * 2 + hkv) * NKEY * 64;
    const bf16_t* Vg = (const bf16_t*)(p.ws + WS_ATTVT) + (size_t)(b * 2 + hkv) * 64 * NKEY;
    const bf16_t* Qg = (const bf16_t*)(p.ws + WS_ATTQ); bf16_t* cat = (bf16_t*)(p.ws + WS_CAT);
    const int hq = hkv * 2 + (F.wave >> 2), q0 = qb * 64 + (F.wave & 3) * 16, c = F.lane & 15, g = F.lane >> 4;
    const int qtok = isctx ? (TL + b * CTXL + q0 + c) : (b * SEQ + q0 + c);
    bf16x8 qf[2];
#pragma unroll
    for (int dc = 0; dc < 2; ++dc) qf[dc] = *(const bf16x8*)(Qg + (size_t)qtok * 256 + hq * 64 + 32 * dc + 8 * g);
    const int srow = F.tid >> 3, sch = F.tid & 7;
    u32x4 kreg = *(const u32x4*)(Kg + (size_t)(kt0 * 64 + srow) * 64 + sch * 8), vreg = *(const u32x4*)(Vg + (size_t)srow * NKEY + kt0 * 64 + sch * 8);
    *(LAS u32x4*)(F.lds + srow * 144 + sch * 16) = kreg; *(LAS u32x4*)(F.lds + 9216 + srow * 144 + sch * 16) = vreg;
    __syncthreads();
    f32x4 O[4]; float mrun = -1e30f, lsum = 0.f;
#pragma unroll
    for (int dt = 0; dt < 4; ++dt) O[dt] = (f32x4){0.f, 0.f, 0.f, 0.f};
    for (int kt = kt0; kt < kt1; ++kt) {
        const int cur = (kt - kt0) & 1; const bool more = kt + 1 < kt1;
        if (more) { kreg = *(const u32x4*)(Kg + (size_t)((kt + 1) * 64 + srow) * 64 + sch * 8); vreg = *(const u32x4*)(Vg + (size_t)srow * NKEY + (kt + 1) * 64 + sch * 8); }
        const LAS unsigned char* Ks = F.lds + cur * 18432; const LAS unsigned char* Vs = Ks + 9216;
        f32x4 st[4];
#pragma unroll
        for (int ks = 0; ks < 4; ++ks) { st[ks] = (f32x4){0.f, 0.f, 0.f, 0.f};
#pragma unroll
            for (int dc = 0; dc < 2; ++dc) { const bf16x8 kf = *(const LAS bf16x8*)(Ks + (16 * ks + c) * 144 + (32 * dc + 8 * g) * 2); st[ks] = __builtin_amdgcn_mfma_f32_16x16x32_bf16(kf, qf[dc], st[ks], 0, 0, 0); } }
        float mx = st[0][0];
#pragma unroll
        for (int ks = 0; ks < 4; ++ks)
#pragma unroll
            for (int i = 0; i < 4; ++i) mx = fmaxf(mx, st[ks][i]);
        mx = fmaxf(mx, __shfl_xor(mx, 16)); mx = fmaxf(mx, __shfl_xor(mx, 32));
        const float mn = fmaxf(mrun, mx), alpha = __builtin_amdgcn_exp2f(mrun - mn); mrun = mn;
        float ps = 0.f;
#pragma unroll
        for (int ks = 0; ks < 4; ++ks)
#pragma unroll
            for (int i = 0; i < 4; ++i) { st[ks][i] = __builtin_amdgcn_exp2f(st[ks][i] - mn); ps += st[ks][i]; }
        lsum = lsum * alpha + ps;
#pragma unroll
        for (int dt = 0; dt < 4; ++dt) O[dt] *= alpha;
#pragma unroll
        for (int kc = 0; kc < 2; ++kc) {
            u32x4 pw; pw.x = cvt_pk_bf16(st[2 * kc][0], st[2 * kc][1]); pw.y = cvt_pk_bf16(st[2 * kc][2], st[2 * kc][3]); pw.z = cvt_pk_bf16(st[2 * kc + 1][0], st[2 * kc + 1][1]); pw.w = cvt_pk_bf16(st[2 * kc + 1][2], st[2 * kc + 1][3]);
            const bf16x8 pf = __builtin_bit_cast(bf16x8, pw);
#pragma unroll
            for (int dt = 0; dt < 4; ++dt) {
                const u32x2 v0 = *(const LAS u32x2*)(Vs + (16 * dt + c) * 144 + (32 * kc + 4 * g) * 2), v1 = *(const LAS u32x2*)(Vs + (16 * dt + c) * 144 + (32 * kc + 16 + 4 * g) * 2);
                u32x4 vw; vw.x = v0.x; vw.y = v0.y; vw.z = v1.x; vw.w = v1.y;
                O[dt] = __builtin_amdgcn_mfma_f32_16x16x32_bf16(__builtin_bit_cast(bf16x8, vw), pf, O[dt], 0, 0, 0);
            }
        }
        if (more) { *(LAS u32x4*)(F.lds + (cur ^ 1) * 18432 + srow * 144 + sch * 16) = kreg; *(LAS u32x4*)(F.lds + (cur ^ 1) * 18432 + 9216 + srow * 144 + sch * 16) = vreg; }
        __syncthreads();
    }
    lsum += __shfl_xor(lsum, 16); lsum += __shfl_xor(lsum, 32);
    const float il = 1.0f / lsum;
#pragma unroll
    for (int dt = 0; dt < 4; ++dt) { u32x2 w; w.x = cvt_pk_bf16(O[dt][0] * il, O[dt][1] * il); w.y = cvt_pk_bf16(O[dt][2] * il, O[dt][3] * il);
        *(u32x2*)(cat + (size_t)qtok * D + 768 + hq * 64 + 16 * dt + 4 * g) = w; }
}
__device__ __forceinline__ void phase_scan_v1(const Params& p, const Frame& F) {
    constexpr int NSCANBLK = 12;
    if (F.bid < NSCANBLK) {
        const int gw = F.bid * 8 + F.wave, mixer = gw >> 5, chain = gw & 31, b = chain >> 3, h = (chain >> 1) & 3, dir = chain & 1;
        if (mixer == 0) rwkv_scan_direct(p, b, h, dir, F.lane); else if (mixer == 1) ssd_scan_direct(p, b, h, dir, F.lane); else gla_scan_direct(p, b, h, dir, F.lane);
    } else {
        for (int item = F.bid - NSCANBLK; item < 544; item += F.nblk - NSCANBLK) att_item(p, F, item);
    }
}
__device__ __forceinline__ void phase_finish(const Params& p, const Frame& F, int l) {
    const float* U = (const float*)(p.ws + WS_U); const float* Yg = (const float*)(p.ws + WS_Y); const float* Ys = Yg + (size_t)T * 256; const float* Yr = Ys + (size_t)T * 256;
    const float* XBC = (const float*)(p.ws + WS_XBC); const float* S = (const float*)(p.ws + WS_RW); const float* G = (const float*)(p.ws + WS_G);
    bf16_t* cat = (bf16_t*)(p.ws + WS_CAT);
    const int c4 = F.lane * 4, head = F.lane >> 4, hc = c4 & 63;
    const f32x4 glan = *(const f32x4*)(p.in[I_GLA_NORM] + l * 64 + hc), ssmn = *(const f32x4*)(p.in[I_SSM_NORM] + l * 256 + c4);
    const float dsk = p.in[I_SSM_D][l * 4 + head];
    const f32x4 lng = *(const f32x4*)(p.in[I_RW_LNG] + l * 256 + c4), lnb = *(const f32x4*)(p.in[I_RW_LNB] + l * 256 + c4), rk = *(const f32x4*)(p.in[I_RW_RK] + l * 256 + c4);
    for (int r = F.bid * 8 + F.wave; r < T; r += F.nblk * 8) {
        const float* ur = U + (size_t)r * NINP; bf16_t* cr = cat + (size_t)r * D;
        {
            const f32x4 o = *(const f32x4*)(Yg + (size_t)r * 256 + c4), gt = *(const f32x4*)(ur + U_GLA_G + c4);
            const float ss = sum16((o.x * o.x + o.y * o.y) + (o.z * o.z + o.w * o.w)); const float rs = 1.0f / sqrtf(ss * (1.0f / 64.0f) + 1e-6f);
            f32x4 y;
#pragma unroll
            for (int e = 0; e < 4; ++e) y[e] = o[e] * rs * glan[e] * silu_f(gt[e]);
            u32x2 w; w.x = cvt_pk_bf16(y[0], y[1]); w.y = cvt_pk_bf16(y[2], y[3]); *(u32x2*)(cr + c4) = w; }
        {
            const f32x4 ys = *(const f32x4*)(Ys + (size_t)r * 256 + c4), xs = *(const f32x4*)(XBC + (size_t)r * 512 + c4), z = *(const f32x4*)(ur + U_SSM_Z + c4);
            f32x4 y; float ss = 0.f;
#pragma unroll
            for (int e = 0; e < 4; ++e) { y[e] = (ys[e] + dsk * xs[e]) * silu_f(z[e]); ss += y[e] * y[e]; }
            ss = wave_sum(ss); const float rs = 1.0f / sqrtf(ss * (1.0f / 256.0f) + 1e-6f);
            u32x2 w; w.x = cvt_pk_bf16(y[0] * rs * ssmn[0], y[1] * rs * ssmn[1]); w.y = cvt_pk_bf16(y[2] * rs * ssmn[2], y[3] * rs * ssmn[3]); *(u32x2*)(cr + 256 + c4) = w; }
        {
            const f32x4 y = *(const f32x4*)(Yr + (size_t)r * 256 + c4); const float* sb = S + ((size_t)r * 4 + head) * 448 + hc;
            const f32x4 rr = *(const f32x4*)(sb), kk = *(const f32x4*)(sb + 192), vv = *(const f32x4*)(sb + 384), gg = *(const f32x4*)(G + (size_t)r * 256 + c4);
            const float mu = sum16((y.x + y.y) + (y.z + y.w)) * (1.0f / 64.0f);
            f32x4 dlt = y - mu; const float var = sum16((dlt.x * dlt.x + dlt.y * dlt.y) + (dlt.z * dlt.z + dlt.w * dlt.w)) * (1.0f / 64.0f);
            const float rs = 1.0f / sqrtf(var + 64e-5f);
            const float dot = sum16((rr.x * kk.x * rk.x + rr.y * kk.y * rk.y) + (rr.z * kk.z * rk.z + rr.w * kk.w * rk.w));
            f32x4 o;
#pragma unroll
            for (int e = 0; e < 4; ++e) o[e] = (dlt[e] * rs * lng[e] + lnb[e] + dot * vv[e]) * gg[e];
            u32x2 w; w.x = cvt_pk_bf16(o[0], o[1]); w.y = cvt_pk_bf16(o[2], o[3]); *(u32x2*)(cr + 512 + c4) = w; }
    }
}
constexpr int NPH_LAYER = 13, NPHASES = NPH_LAYER * DEPTH;
__global__ void __launch_bounds__(512) mega(Params p0) {
    extern __shared__ __attribute__((aligned(16))) unsigned char lds_raw[];
    cg::grid_group grid = cg::this_grid();
    for (int ph = p0.ph_lo; ph < p0.ph_hi; ++ph) {
        int tid_ = threadIdx.x; asm volatile("" : "+v"(tid_));
        Params p = p0; asm volatile("" : "+s"(p.ws), "+s"(p.out));
        int bid_ = blockIdx.x, nblk_ = gridDim.x; asm volatile("" : "+s"(bid_), "+s"(nblk_));
        Frame F; F.bid = bid_; F.nblk = nblk_; F.lds = (LAS unsigned char*)lds_raw; F.tid = tid_; F.lane = F.tid & 63; F.wave = __builtin_amdgcn_readfirstlane(F.tid >> 6);
        const int l = ph / NPH_LAYER, s = ph % NPH_LAYER;
        if (s == 0) {
#ifndef SKIP_A
 if (l == 0) phase_mod_init(p, F); phase_conv(p, F, l);
#endif
 }
        else if (s == 1 || s == 4 || s == 10) {
#ifndef SKIP_B
 phase_normmod(p, F, l, s == 1 ? 0 : (s == 4 ? 1 : 2));
#endif
 }
        else if (s == 2 || s == 11) { const int f = s == 11;
            pg8::Gemm g; g.A = (const bf16_t*)(p.ws + WS_HA); g.Bt = (const bf16_t*)(p.ws + WS_WUP) + (size_t)f * NUP * D; g.M = T; g.N = NUP; g.K = D;
            pg8::StaticOrder so; so.init(T, NUP, F.nblk, F.bid);
            pg8::EpiSwiglu e; e.O = (bf16_t*)(p.ws + WS_HID); e.ldc = DFF;

#ifndef SKIP_C
 pg8::gemm_phase<pg8::EpiSwiglu, pg8::StaticOrder, false>(F.lds, g, so, e, nullptr);
#endif
 }
        else if (s == 3 || s == 12 || s == 9) { const int f = s == 12; const bool isout = s == 9;
            pg8::Gemm g; g.A = isout ? (const bf16_t*)(p.ws + WS_CAT) : (const bf16_t*)(p.ws + WS_HID);
            g.Bt = isout ? (const bf16_t*)(p.ws + WS_WOUT) : (const bf16_t*)(p.ws + WS_WDN) + (size_t)f * D * DFF; g.M = T; g.N = D; g.K = isout ? D : DFF;
            pg8::StaticOrder so; so.init(T, D, F.nblk, F.bid);
            pg8::EpiResid e; e.xlat = p.out; e.xctx = (float*)(p.ws + WS_XCTX); e.gate = (const float*)(p.ws + WS_MOD) + (size_t)(l * 5) * NMODC + (isout ? 5 : (f ? 8 : 2)) * D; e.coef = isout ? 1.0f : 0.5f;

#ifndef SKIP_D
 pg8::gemm_phase<pg8::EpiResid, pg8::StaticOrder, false>(F.lds, g, so, e, nullptr);
#endif
 }
        else if (s == 5) {
            pg8::Gemm g; g.A = (const bf16_t*)(p.ws + WS_HA); g.Bt = (const bf16_t*)(p.ws + WS_WIN); g.M = T; g.N = NINP; g.K = D;
            pg8::StaticOrder so; so.init(T, NINP, F.nblk, F.bid);
            pg8::EpiStoreF32 e; e.C = (float*)(p.ws + WS_U); e.ldc = NINP;

#ifndef SKIP_E
 pg8::gemm_phase<pg8::EpiStoreF32, pg8::StaticOrder, false>(F.lds, g, so, e, nullptr);
#endif
 }
        else if (s == 6) {
#ifndef SKIP_F
 phase_prep(p, F, l);
#endif
 }
        else if (s == 7) {
#ifndef SKIP_G
 phase_scan_v1(p, F);
#endif
 }
        else if (s == 8) {
#ifndef SKIP_H
 phase_finish(p, F, l);
#endif
 }
        if (ph + 1 < p0.ph_hi) grid.sync();
    }
}

extern "C" void kernel_launch(void* const* d_in, const int* in_sizes, int n_in, void* d_out, int out_size, void* d_ws, size_t ws_size, hipStream_t stream) {
    static int grid_blocks = 0;
    if (!grid_blocks) {
        int dev = 0, cus = 0, per_cu = 0;
        (void)hipGetDevice(&dev);
        (void)hipDeviceGetAttribute(&cus, hipDeviceAttributeMultiprocessorCount, dev);
        (void)hipFuncSetAttribute((const void*)mega, hipFuncAttributeMaxDynamicSharedMemorySize, LDS_BYTES);
        (void)hipOccupancyMaxActiveBlocksPerMultiprocessor(&per_cu, (const void*)mega, 512, LDS_BYTES);
        if (per_cu < 1) per_cu = 1;
        grid_blocks = cus * per_cu;
        if (n_in != N_INPUTS || out_size != TL * D || ws_size < WS_END) { fprintf(stderr, "kernel_launch: unexpected sizes n_in %d out %d ws %zu (need %zu)\n", n_in, out_size, ws_size, (size_t)WS_END); grid_blocks = -1; }
    }
    if (grid_blocks < 0) return;
    Params p{};
    for (int i = 0; i < N_INPUTS; ++i) p.in[i] = (const float*)d_in[i];
    p.out = (float*)d_out; p.ws = (unsigned char*)d_ws; p.ph_lo = 0; p.ph_hi = NPHASES;
    void* args[] = {&p};
    hipError_t e = hipLaunchCooperativeKernel((void*)mega, dim3(grid_blocks), dim3(512), args, LDS_BYTES, stream);
    if (e != hipSuccess) fprintf(stderr, "cooperative launch failed: %s (grid %d)\n", hipGetErrorString(e), grid_blocks);
}
```

```cpp
#include <hip/hip_runtime.h>
#include <hip/hip_cooperative_groups.h>
#include <cstdio>
#include <cstdint>
namespace cg = cooperative_groups;
constexpr int D = 1024, NBATCH = 4, SEQ = 4096, DEPTH = 4, CTXL = 256;
constexpr int TL = NBATCH * SEQ, TC = NBATCH * CTXL, T = TL + TC;
constexpr int DFF = 2816, NUP = 2 * DFF, NIN = 3092, NINP = 3328, NMODC = 9 * D;
namespace pg8 {
#define PG8_LAS __attribute__((address_space(3)))
typedef unsigned short bf16_t;
typedef short bf16x8 __attribute__((ext_vector_type(8)));
typedef float f32x4 __attribute__((ext_vector_type(4)));
typedef unsigned u32x4 __attribute__((ext_vector_type(4)));
constexpr int BM = 256, BK = 64, HALF = 128, HTB = HALF * BK * 2  , STAGE_BYTES = 8 * HTB, NXCD = 8, WGM = 8;

__host__ __device__ __forceinline__ int lds_byte(int r, int c) { const int st = (r >> 4) * 2 + (c >> 5), rr = r & 15, cc = c & 31, ob = rr * 64 + cc * 2; return st * 1024 + (ob ^ (((ob >> 9) & 1) << 5)); }
__host__ __device__ __forceinline__ void stage_rc(int b, int& R, int& C) { const int st = b / 1024, sb = b % 1024, swz = sb ^ (((sb >> 9) & 1) << 5); R = (st >> 1) * 16 + swz / 64; C = (st & 1) * 32 + (swz % 64) / 2; }
__host__ __device__ __forceinline__ int perm32(int rho) { const int n = rho >> 4, i = rho & 15; return 8 * (i >> 2) + 4 * n + (i & 3); }

struct Unit { int pm, pn, ks; };
struct Gemm { const bf16_t* A; const bf16_t* Bt; int M, N, K, ldk; };

struct StaticOrder {
    int nM, nN, nwg, G, c;
    __host__ __device__ void init(int M, int N, int G_, int c_) { nM = M / BM; nN = N / BM; nwg = nM * nN; G = G_; c = c_; }
    __host__ __device__ bool next(int i, Unit& u) const {
        const long L = (long)i * G + c; if (L >= nwg) return false;
        int wgid = (int)L; { const int q = nwg / NXCD, r = nwg % NXCD, xcd = wgid % NXCD, off = wgid / NXCD; wgid = (xcd < r ? xcd * (q + 1) : r * (q + 1) + (xcd - r) * q) + off; }
        const int nig = WGM * nN, gid = wgid / nig, fm = gid * WGM, gsz = (nM - fm) < WGM ? (nM - fm) : WGM;
        u.pm = fm + ((wgid % nig) % gsz); u.pn = (wgid % nig) / gsz; u.ks = 0; return true;
    }
    __device__ __forceinline__ void a_ready(const Unit&) const {}
    __device__ __forceinline__ void done(const Unit&) const {}
};
__device__ __forceinline__ unsigned cvt_pk_bf16(float lo, float hi) { unsigned r; asm volatile("s_nop 0\n\tv_cvt_pk_bf16_f32 %0, %1, %2" : "=v"(r) : "v"(lo), "v"(hi)); return r; }
typedef float f32x2 __attribute__((ext_vector_type(2)));
__device__ __forceinline__ float silu_fast(float a) { return a * __builtin_amdgcn_rcpf(1.0f + __builtin_amdgcn_exp2f(-1.44269504f * a)); }
struct EpiSwiglu {
    static constexpr bool PERM = true, AFTER_DRAIN = false;
    bf16_t* O; int ldc;
    __device__ __forceinline__ void operator()(const f32x4 (&acc)[2][2][4][2], const Unit& u, int wr, int wc, int fr, int fq) const {
        const int row0 = u.pm * BM + wr * 64 + fr, col0 = u.pn * HALF + wc * 32 + 8 * fq;
#pragma unroll
        for (int ai = 0; ai < 2; ++ai)
#pragma unroll
            for (int m = 0; m < 4; ++m) {
                bf16_t* rowp = O + (size_t)(row0 + ai * HALF + m * 16) * ldc + col0;
                const f32x4 a0 = acc[ai][0][m][0], a1 = acc[ai][0][m][1], b0 = acc[ai][1][m][0], b1 = acc[ai][1][m][1];
                f32x4 h0, h1;
#pragma unroll
                for (int j = 0; j < 4; ++j) { h0[j] = silu_fast(a0[j]) * b0[j]; h1[j] = silu_fast(a1[j]) * b1[j]; }
                u32x4 w; w.x = cvt_pk_bf16(h0[0], h0[1]); w.y = cvt_pk_bf16(h0[2], h0[3]); w.z = cvt_pk_bf16(h1[0], h1[1]); w.w = cvt_pk_bf16(h1[2], h1[3]);
                *(u32x4*)rowp = w;
            }
    }
};
struct EpiResid {
    static constexpr bool PERM = false, AFTER_DRAIN = false;
    float* xlat; float* xctx; const float* gate; float coef;
    __device__ __forceinline__ void operator()(const f32x4 (&acc)[2][2][4][2], const Unit& u, int wr, int wc, int fr, int fq) const {
        const int row0 = u.pm * BM + wr * 64 + fr, col0 = u.pn * BM + wc * 32 + 4 * fq;
        const int mr = (u.pm < 64) ? (u.pm >> 4) : 4;
        const float* gr = gate + (size_t)mr * NMODC + col0;
        float* xb = (u.pm < 64 ? xlat + (size_t)row0 * D : xctx + (size_t)(row0 - TL) * D) + col0;
#pragma unroll
        for (int bj = 0; bj < 2; ++bj)
#pragma unroll
            for (int n = 0; n < 2; ++n) {
                const f32x4 gv = *(const f32x4*)(gr + bj * HALF + n * 16) * coef;
#pragma unroll
                for (int ai = 0; ai < 2; ++ai)
#pragma unroll
                    for (int m = 0; m < 4; ++m) { float* q = xb + (size_t)(ai * HALF + m * 16) * D + bj * HALF + n * 16; f32x4 xv = *(const f32x4*)q; xv += gv * acc[ai][bj][m][n]; *(f32x4*)q = xv; }
                asm volatile("" ::: "memory");
            }
    }
};
struct EpiStoreF32 {
    static constexpr bool PERM = false, AFTER_DRAIN = false;
    float* C; int ldc;
    __device__ __forceinline__ void operator()(const f32x4 (&acc)[2][2][4][2], const Unit& u, int wr, int wc, int fr, int fq) const {
        const int row0 = u.pm * BM + wr * 64 + fr, col0 = u.pn * BM + wc * 32 + 4 * fq;
#pragma unroll
        for (int ai = 0; ai < 2; ++ai)
#pragma unroll
            for (int m = 0; m < 4; ++m) { float* rowp = C + (size_t)(row0 + ai * HALF + m * 16) * ldc + col0;
#pragma unroll
                for (int bj = 0; bj < 2; ++bj)
#pragma unroll
                    for (int n = 0; n < 2; ++n) *(f32x4*)(rowp + bj * HALF + n * 16) = acc[ai][bj][m][n]; }
    }
};
struct EpiStoreBf16 {
    static constexpr bool PERM = true, AFTER_DRAIN = false;
    bf16_t* O; int ldc;
    __device__ __forceinline__ void operator()(const f32x4 (&acc)[2][2][4][2], const Unit& u, int wr, int wc, int fr, int fq) const {
        const int row0 = u.pm * BM + wr * 64 + fr, col0 = u.pn * BM + wc * 32 + 8 * fq;
#pragma unroll
        for (int ai = 0; ai < 2; ++ai)
#pragma unroll
            for (int m = 0; m < 4; ++m) { bf16_t* rowp = O + (size_t)(row0 + ai * HALF + m * 16) * ldc + col0;
#pragma unroll
                for (int bj = 0; bj < 2; ++bj) { const f32x4 v0 = acc[ai][bj][m][0], v1 = acc[ai][bj][m][1];
                    u32x4 w; w.x = cvt_pk_bf16(v0[0], v0[1]); w.y = cvt_pk_bf16(v0[2], v0[3]); w.z = cvt_pk_bf16(v1[0], v1[1]); w.w = cvt_pk_bf16(v1[2], v1[3]);
                    *(u32x4*)(rowp + bj * HALF) = w; } }
    }
};
struct SliceOrder {
    int nslice, c;
    __device__ __forceinline__ bool next(int i, Unit& u) const { if (i > 0 || c >= 16 * nslice) return false; u.ks = c % nslice; const int q = c / nslice; u.pm = 64 + (q >> 2); u.pn = q & 3; return true; }
    __device__ __forceinline__ void a_ready(const Unit&) const {}
    __device__ __forceinline__ void done(const Unit&) const {}
};
struct EpiStorePart {
    static constexpr bool PERM = false, AFTER_DRAIN = false;
    float* part; int nslice;
    __device__ __forceinline__ void operator()(const f32x4 (&acc)[2][2][4][2], const Unit& u, int wr, int wc, int fr, int fq) const {
        int frr = fr, fqq = fq; asm volatile("" : "+v"(frr), "+v"(fqq));
        float* C = part + (size_t)((((u.pm - 64) * 4 + u.pn) * nslice + u.ks)) * 65536 + (size_t)(wr * 64 + frr) * 256 + wc * 32 + 4 * fqq;
#pragma unroll
        for (int ai = 0; ai < 2; ++ai)
#pragma unroll
            for (int m = 0; m < 4; ++m) { float* rowp = C + (size_t)(ai * HALF + m * 16) * 256;
#pragma unroll
                for (int bj = 0; bj < 2; ++bj)
#pragma unroll
                    for (int n = 0; n < 2; ++n) *(f32x4*)(rowp + bj * HALF + n * 16) = acc[ai][bj][m][n]; }
    }
};
template <class Epi, class Sched, bool STAMP = false>
__device__ __forceinline__ void gemm_phase(PG8_LAS unsigned char* lds, const Gemm g, const Sched& S, const Epi& E, unsigned long long* stamps) {
    int tid_raw = threadIdx.x; asm volatile("" : "+v"(tid_raw)); const int tid = tid_raw, wid = __builtin_amdgcn_readfirstlane(tid >> 6), lane = tid & 63, wr = wid >> 2, wc = wid & 3, fr = lane & 15, fq = lane >> 4;
    const int K = g.K, nt = K / BK, LD = g.ldk;
    int ts_lo = 0, ts_hi = 0, nts = 0; const unsigned long long rt_entry = STAMP ? (unsigned long long)wall_clock64() : 0ull;
#define PG8_STAMP() do { if (STAMP && wid == 0 && nts < 64) { const unsigned long long _c = (unsigned long long)clock64(); \
        ts_lo = (lane == nts) ? (int)(unsigned)_c : ts_lo; ts_hi = (lane == nts) ? (int)(unsigned)(_c >> 32) : ts_hi; ++nts; } } while (0)
    PG8_STAMP();
    unsigned voffA[2], voffB[2];
#pragma unroll
    for (int i = 0; i < 2; ++i) { int R, C; stage_rc(tid * 16 + i * 8192, R, C); const int Rb = Epi::PERM ? ((R & ~31) + perm32(R & 31)) : R;
        voffA[i] = (unsigned)(R * LD + C) * 2u; voffB[i] = (unsigned)(Rb * LD + C) * 2u; }
    const size_t kstep = (size_t)(BK * 2);
    const size_t hstep = (size_t)HALF * LD * 2;
    const size_t tstep = 2 * hstep;
    const unsigned ldsw = (unsigned)wid * 1024u;
    const int aoff = lds_byte(wr * 64 + fr, fq * 8), boff = lds_byte(wc * 32 + fr, fq * 8);
#define PG8_SA(b, h) (((b) * 2 + (h)) * HTB)
#define PG8_SB(b, h) ((4 + (b) * 2 + (h)) * HTB)
#define PG8_STAGE(bufoff, gbase, voff) do { _Pragma("unroll") for (int _i = 0; _i < 2; ++_i) \
        __builtin_amdgcn_global_load_lds((const unsigned*)((const char*)(gbase) + (voff)[_i]), (PG8_LAS unsigned*)(lds + (bufoff) + ldsw + _i * 8192), 16, 0, 0); } while (0)
#define PG8_LDA(dst, b, h) do { _Pragma("unroll") for (int m = 0; m < 4; ++m) _Pragma("unroll") for (int k = 0; k < 2; ++k) dst[m][k] = *(const PG8_LAS bf16x8*)(lds + PG8_SA(b, h) + aoff + m * 2048 + k * 1024); } while (0)
#define PG8_LDB(dst, b, h) do { _Pragma("unroll") for (int n = 0; n < 2; ++n) _Pragma("unroll") for (int k = 0; k < 2; ++k) dst[n][k] = *(const PG8_LAS bf16x8*)(lds + PG8_SB(b, h) + boff + n * 2048 + k * 1024); } while (0)
#define PG8_MMA(ai, bj, At, Bt) do { __builtin_amdgcn_s_setprio(1); _Pragma("unroll") for (int m = 0; m < 4; ++m) _Pragma("unroll") for (int n = 0; n < 2; ++n) _Pragma("unroll") for (int k = 0; k < 2; ++k) \
        acc[ai][bj][m][n] = __builtin_amdgcn_mfma_f32_16x16x32_bf16(Bt[n][k], At[m][k], acc[ai][bj][m][n], 0, 0, 0); __builtin_amdgcn_s_setprio(0); } while (0)
#define PG8_WAIT_V(n) asm volatile("s_waitcnt vmcnt(" #n ")" ::: "memory")
#define PG8_WAIT_L(n) asm volatile("s_waitcnt lgkmcnt(" #n ")" ::: "memory")
#define PG8_BAR __builtin_amdgcn_s_barrier()
#define PG8_SCHED __builtin_amdgcn_sched_barrier(0)
    Unit cur, nxt; int ui = 0;
    if (!S.next(0, cur)) return;
    f32x4 acc[2][2][4][2];
#pragma unroll
    for (int a = 0; a < 2; ++a)
#pragma unroll
        for (int b = 0; b < 2; ++b)
#pragma unroll
            for (int m = 0; m < 4; ++m)
#pragma unroll
                for (int n = 0; n < 2; ++n) acc[a][b][m][n] = (f32x4){0.f, 0.f, 0.f, 0.f};
    bf16x8 At[4][2], B0[2][2], B1[2][2];
    const char* cA = (const char*)g.A + (size_t)cur.pm * tstep + (size_t)cur.ks * K * 2; const char* cB = (const char*)g.Bt + (size_t)cur.pn * tstep + (size_t)cur.ks * K * 2;
    S.a_ready(cur);
    PG8_STAGE(PG8_SB(0, 0), cB, voffB); PG8_STAGE(PG8_SA(0, 0), cA, voffA); PG8_STAGE(PG8_SB(0, 1), cB + hstep, voffB); PG8_STAGE(PG8_SA(0, 1), cA + hstep, voffA);
    if (wr == 1) PG8_BAR;
    PG8_WAIT_V(4); PG8_BAR;
    PG8_STAGE(PG8_SB(1, 0), cB + kstep, voffB); PG8_STAGE(PG8_SA(1, 0), cA + kstep, voffA); PG8_STAGE(PG8_SB(1, 1), cB + hstep + kstep, voffB);
    PG8_WAIT_V(6); PG8_BAR;
    PG8_STAMP();
    for (;;) {
        const bool has_next = S.next(ui + 1, nxt);
        const char* nA = has_next ? (const char*)g.A + (size_t)nxt.pm * tstep + (size_t)nxt.ks * K * 2 : cA; const char* nB = has_next ? (const char*)g.Bt + (size_t)nxt.pn * tstep + (size_t)nxt.ks * K * 2 : cB;
        for (int t = 0; t < nt; t += 2) {
            const bool last = (t == nt - 2);
            const char* a1 = cA + (size_t)(t + 1) * kstep;
            const char* a2 = last ? nA : cA + (size_t)(t + 2) * kstep; const char* b2 = last ? nB : cB + (size_t)(t + 2) * kstep;
            const char* a3 = a2 + kstep; const char* b3 = b2 + kstep;
            if (last && has_next) S.a_ready(nxt);
            PG8_LDB(B0, 0, 0); PG8_SCHED; PG8_LDA(At, 0, 0); PG8_STAGE(PG8_SA(1, 1), a1 + hstep, voffA);
            PG8_WAIT_L(8); PG8_BAR; PG8_WAIT_L(0); PG8_MMA(0, 0, At, B0); PG8_BAR; PG8_SCHED;
            PG8_LDB(B1, 0, 1); PG8_STAGE(PG8_SB(0, 0), b2, voffB);
            PG8_BAR; PG8_WAIT_L(0); PG8_MMA(0, 1, At, B1); PG8_BAR;
            PG8_LDA(At, 0, 1); PG8_STAGE(PG8_SA(0, 0), a2, voffA);
            PG8_BAR; PG8_WAIT_L(0); PG8_MMA(1, 0, At, B0); PG8_BAR; PG8_SCHED;
            PG8_STAGE(PG8_SB(0, 1), b2 + hstep, voffB);
            PG8_WAIT_V(6); PG8_BAR; PG8_MMA(1, 1, At, B1); PG8_BAR;
            PG8_LDB(B0, 1, 0); PG8_SCHED; PG8_LDA(At, 1, 0); PG8_STAGE(PG8_SA(0, 1), a2 + hstep, voffA);
            PG8_WAIT_L(8); PG8_BAR; PG8_WAIT_L(0); PG8_MMA(0, 0, At, B0); PG8_BAR; PG8_SCHED;
            PG8_LDB(B1, 1, 1); PG8_STAGE(PG8_SB(1, 0), b3, voffB);
            PG8_BAR; PG8_WAIT_L(0); PG8_MMA(0, 1, At, B1); PG8_BAR;
            PG8_LDA(At, 1, 1); PG8_STAGE(PG8_SA(1, 0), a3, voffA);
            PG8_BAR; PG8_WAIT_L(0); PG8_MMA(1, 0, At, B0); PG8_BAR; PG8_SCHED;
            PG8_STAGE(PG8_SB(1, 1), b3 + hstep, voffB);
            PG8_WAIT_V(6); PG8_BAR; PG8_MMA(1, 1, At, B1); PG8_BAR;
        }
        PG8_STAMP();
        if constexpr (!Epi::AFTER_DRAIN) { E(acc, cur, wr, wc, fr, fq); S.done(cur); }
        PG8_STAMP();
        if (!has_next) break;
#pragma unroll
        for (int a = 0; a < 2; ++a)
#pragma unroll
            for (int b = 0; b < 2; ++b)
#pragma unroll
                for (int m = 0; m < 4; ++m)
#pragma unroll
                    for (int n = 0; n < 2; ++n) acc[a][b][m][n] = (f32x4){0.f, 0.f, 0.f, 0.f};
        cur = nxt; cA = nA; cB = nB; ++ui;
    }
    PG8_WAIT_V(0);
    if (wr == 0) PG8_BAR;
    PG8_BAR;
    if constexpr (Epi::AFTER_DRAIN) { E.fused(acc, cur, wr, wc, fr, fq, lds, wid, lane); S.done(cur); }
    PG8_STAMP();
    if (STAMP && wid == 0) { stamps[lane] = lane < nts ? (((unsigned long long)(unsigned)ts_hi << 32) | (unsigned)ts_lo) : 0ull;
        if (lane == 62) stamps[62] = rt_entry; if (lane == 63) stamps[63] = (unsigned long long)wall_clock64(); }
#undef PG8_STAMP
#undef PG8_SA
#undef PG8_SB
#undef PG8_STAGE
#undef PG8_LDA
#undef PG8_LDB
#undef PG8_MMA
#undef PG8_WAIT_V
#undef PG8_WAIT_L
#undef PG8_BAR
#undef PG8_SCHED
}
}
#define LAS __attribute__((address_space(3)))
typedef unsigned short bf16_t;
using pg8::f32x4; using pg8::u32x4; using pg8::bf16x8; using pg8::cvt_pk_bf16;
typedef float f32x2 __attribute__((ext_vector_type(2)));
typedef unsigned u32x2 __attribute__((ext_vector_type(2)));
#define LDS_WAIT() asm volatile("s_waitcnt lgkmcnt(0)" ::: "memory")

enum { I_X = 0, I_C, I_CTX, I_CCTX, I_NORMG, I_WMOD, I_BMOD, I_FFNIN, I_FFNOUT, I_WIN, I_WOUT, I_GLA_WDEC, I_GLA_BDEC, I_GLA_NORM,
       I_SSM_CONVW, I_SSM_CONVB, I_SSM_DTB, I_SSM_ALOG, I_SSM_D, I_SSM_NORM, I_RW_MU, I_RW_W0, I_RW_WDEC, I_RW_A0, I_RW_WA, I_RW_WG,
       I_RW_KK, I_RW_KA, I_RW_RK, I_RW_LNG, I_RW_LNB, I_ATT_QN, I_ATT_KN, N_INPUTS };
struct Params { const float* in[N_INPUTS]; float* out; unsigned char* ws; int ph_lo, ph_hi; };

constexpr size_t al256(size_t x) { return (x + 255) & ~(size_t)255; }
constexpr size_t WS_WUP = 0;
constexpr size_t WS_WDN = WS_WUP + al256((size_t)2 * NUP * D * 2);
constexpr size_t WS_WIN = WS_WDN + al256((size_t)2 * D * DFF * 2);
constexpr size_t WS_WOUT = WS_WIN + al256((size_t)NINP * D * 2);
constexpr size_t WS_MOD = WS_WOUT + al256((size_t)D * D * 2);
constexpr size_t WS_XCTX = WS_MOD + al256((size_t)DEPTH * 5 * NMODC * 4);
constexpr size_t WS_HID = WS_XCTX + al256((size_t)TC * D * 4);
constexpr size_t WS_HA = WS_HID + al256((size_t)T * DFF * 2);
constexpr size_t WS_RW = WS_HID;
constexpr size_t WS_U = WS_HA + al256((size_t)T * D * 2);
constexpr size_t WS_G = WS_U + al256((size_t)T * NINP * 2);
constexpr size_t WS_DEC = WS_G + al256((size_t)T * 256 * 4);
constexpr size_t WS_XBC = WS_DEC + al256((size_t)T * 256 * 4);
constexpr size_t WS_DT = WS_XBC + al256((size_t)T * 512 * 4);
constexpr size_t WS_ATTQ = WS_DT + al256((size_t)T * 16 * 4);
constexpr size_t WS_ATTK = WS_ATTQ + al256((size_t)T * 256 * 2);
constexpr size_t WS_ATTVT = WS_ATTK + al256((size_t)T * 128 * 2);
constexpr size_t WS_Y = WS_ATTVT + al256((size_t)T * 128 * 2);
constexpr size_t WS_Y2 = WS_Y + al256((size_t)3 * T * 256 * 4);
constexpr int NSEG = 68, NCHAIN = 32;
constexpr size_t WS_RWE = WS_Y2 + al256((size_t)3 * T * 256 * 4);
constexpr size_t WS_RWP = WS_RWE + al256((size_t)NCHAIN * NSEG * 4096 * 4);
constexpr size_t WS_SSE = WS_RWP + al256((size_t)NCHAIN * NSEG * 4096 * 4);
constexpr size_t WS_GLE = WS_SSE + al256((size_t)NCHAIN * NSEG * 4096 * 4);
constexpr size_t WS_ZRW = WS_GLE + al256((size_t)NCHAIN * NSEG * 2048 * 4);
constexpr size_t WS_ZSS = WS_ZRW + al256((size_t)2 * T * 256 * 4);
constexpr size_t WS_CAT = WS_ZRW;
constexpr size_t WS_ATTO = WS_U - (size_t)T * 256 * 2;
constexpr size_t WS_ZGL = WS_ZSS + al256((size_t)2 * T * 256 * 4);
constexpr size_t WS_SDEC = WS_ZGL + al256((size_t)2 * T * 128 * 4);
constexpr size_t WS_GDEC = WS_SDEC + al256((size_t)NCHAIN * NSEG * 4);
constexpr size_t WS_BAR = WS_GDEC + al256((size_t)NCHAIN * NSEG * 32 * 4);
constexpr size_t WS_END = WS_BAR + 16384;
static_assert((size_t)T * 4 * 7 * 64 * 4 <= (WS_ATTO - WS_HID), "RWKV streams + attention output must fit the hid|hA region");
static_assert((size_t)T * D * 2 <= (size_t)2 * T * 256 * 4 && WS_END <= (size_t)738000000, "workspace budget");
constexpr int LDS_BYTES = 131072 + 1024;
constexpr int NKEY = SEQ + CTXL;

struct Frame { LAS unsigned char* lds; int tid, lane, wave, bid, nblk; };

__device__ __forceinline__ float wave_sum(float v) {
#pragma unroll
    for (int o = 1; o < 64; o <<= 1) v += __shfl_xor(v, o);
    return v;
}
__device__ __forceinline__ float sum16(float v) { v += __shfl_xor(v, 1); v += __shfl_xor(v, 2); v += __shfl_xor(v, 4); v += __shfl_xor(v, 8); return v; }
__device__ __forceinline__ float sigmoid_f(float x) { return 1.0f / (1.0f + expf(-x)); }
__device__ __forceinline__ float silu_f(float x) { return x * sigmoid_f(x); }
__device__ __forceinline__ float sigmoid_fast(float x) { return __builtin_amdgcn_rcpf(1.0f + __expf(-x)); }
__device__ __forceinline__ float silu_fast2(float x) { return x * sigmoid_fast(x); }
__device__ __forceinline__ float softplus_f(float x) { return fmaxf(x, 0.f) + log1pf(expf(-fabsf(x))); }
__device__ __forceinline__ float bf2f(bf16_t x) { return __uint_as_float((unsigned)x << 16); }
__device__ __forceinline__ f32x4 ldbf4(const bf16_t* q) { const u32x2 w = *(const u32x2*)q; f32x4 o; o.x = __uint_as_float(w.x << 16); o.y = __uint_as_float(w.x & 0xffff0000u); o.z = __uint_as_float(w.y << 16); o.w = __uint_as_float(w.y & 0xffff0000u); return o; }
__device__ __forceinline__ int modrow_of(int r) { return r < TL ? (r >> 12) : 4; }
__device__ __forceinline__ void seq_of(int r, int& pos, int& len) { if (r < TL) { pos = r & (SEQ - 1); len = SEQ; } else { pos = (r - TL) & (CTXL - 1); len = CTXL; } }
__device__ __forceinline__ float* xrow_of(const Params& p, int r) { return r < TL ? p.out + (size_t)r * D : (float*)(p.ws + WS_XCTX) + (size_t)(r - TL) * D; }

__device__ __forceinline__ void conv_item(const float* __restrict__ W, int ldw, int srclimit, int srccol0, int k0, bf16_t* dst, int K, LAS float* scr, int lane) {
    { float tv[32]; const int j = lane & 31, sc = srccol0 + j; const bool ok = sc < srclimit; const float* wp = W + (size_t)(k0 + (lane >> 5)) * ldw + sc;
#pragma unroll
      for (int i = 0; i < 32; ++i) tv[i] = ok ? wp[(size_t)(2 * i) * ldw] : 0.f;
#pragma unroll
      for (int i = 0; i < 32; ++i) scr[(2 * i + (lane >> 5)) * 33 + j] = tv[i]; }
    LDS_WAIT();
    const int c = lane & 7;
#pragma unroll
    for (int jj = 0; jj < 4; ++jj) { const int n = (lane >> 3) + 8 * jj; const LAS float* s = scr + (8 * c) * 33 + n;
        u32x4 o; o.x = cvt_pk_bf16(s[0], s[33]); o.y = cvt_pk_bf16(s[66], s[99]); o.z = cvt_pk_bf16(s[132], s[165]); o.w = cvt_pk_bf16(s[198], s[231]);
        *(u32x4*)(dst + (size_t)n * K + k0 + 8 * c) = o; }
    LDS_WAIT();
}
__device__ __forceinline__ void phase_conv(const Params& p, const Frame& F, int l, int mask, int gw, int NGW) {
    LAS float* scr = (LAS float*)(F.lds + F.wave * 8448);
    bf16_t* wup = (bf16_t*)(p.ws + WS_WUP); bf16_t* wdn = (bf16_t*)(p.ws + WS_WDN); bf16_t* win = (bf16_t*)(p.ws + WS_WIN); bf16_t* wout = (bf16_t*)(p.ws + WS_WOUT);
    constexpr int I_UP = 16 * 176, I_DN = 44 * 32, I_INW = 16 * 104, I_OUTW = 16 * 32;
    const int n0_ = (mask & 1) ? I_UP : 0, n1_ = (mask & 2) ? I_UP : 0, n2_ = (mask & 4) ? I_DN : 0, n3_ = (mask & 8) ? I_DN : 0, n4_ = (mask & 16) ? I_INW : 0, n5_ = (mask & 32) ? I_OUTW : 0;
    const int NITEMS = n0_ + n1_ + n2_ + n3_ + n4_ + n5_;
    for (int it = gw; it < NITEMS; it += NGW) {
        int r = it;
        if (r < n0_ + n1_) { const int f = (r < n0_) ? 0 : 1; r -= (f && n0_) ? n0_ : 0; const int kb = r / 176, nb = r % 176, n0 = 32 * nb, pn = n0 >> 8, bj = (n0 >> 7) & 1, j0 = n0 & 127;
            conv_item(p.in[I_FFNIN] + (size_t)(l * 2 + f) * D * NUP, NUP, NUP, bj * DFF + 128 * pn + j0, 64 * kb, wup + (size_t)f * NUP * D + (size_t)n0 * D, D, scr, F.lane); continue; }
        r -= n0_ + n1_;
        if (r < n2_ + n3_) { const int f = (r < n2_) ? 0 : 1; r -= (f && n2_) ? n2_ : 0; const int kb = r / 32, nb = r % 32, n0 = 32 * nb;
            conv_item(p.in[I_FFNOUT] + (size_t)(l * 2 + f) * DFF * D, D, D, n0, 64 * kb, wdn + (size_t)f * D * DFF + (size_t)n0 * DFF, DFF, scr, F.lane); continue; }
        r -= n2_ + n3_;
        if (r < n4_) { const int kb = r / 104, nb = r % 104, n0 = 32 * nb;
            conv_item(p.in[I_WIN] + (size_t)l * D * NIN, NIN, NIN, n0, 64 * kb, win + (size_t)n0 * D, D, scr, F.lane); continue; }
        r -= n4_;
        { const int kb = r / 32, nb = r % 32, n0 = 32 * nb;
            conv_item(p.in[I_WOUT] + (size_t)l * D * D, D, D, n0, 64 * kb, wout + (size_t)n0 * D, D, scr, F.lane); }
    }
}
__device__ __forceinline__ void phase_mod_init(const Params& p, const Frame& F) {
    LAS float* sc = (LAS float*)F.lds; LAS float* part = sc + 5 * D;
    for (int i = F.tid; i < 5 * D; i += 512) { const int r = i >> 10, k = i & 1023; const float cv = r < 4 ? p.in[I_C][r * D + k] : p.in[I_CCTX][k]; sc[i] = silu_f(cv); }
    __syncthreads();
    float* mod = (float*)(p.ws + WS_MOD);
    for (int item = F.bid; item < DEPTH * 144; item += F.nblk) {
        const int l = item / 144, cb = item % 144;
        const float* W = p.in[I_WMOD] + (size_t)l * D * NMODC + cb * 64 + F.lane;
        float a0 = 0.f, a1 = 0.f, a2 = 0.f, a3 = 0.f, a4 = 0.f;
#pragma unroll 8
        for (int k = F.wave * 128; k < F.wave * 128 + 128; ++k) { const float w = W[(size_t)k * NMODC]; a0 += sc[k] * w; a1 += sc[D + k] * w; a2 += sc[2 * D + k] * w; a3 += sc[3 * D + k] * w; a4 += sc[4 * D + k] * w; }
        part[(F.wave * 5 + 0) * 64 + F.lane] = a0; part[(F.wave * 5 + 1) * 64 + F.lane] = a1; part[(F.wave * 5 + 2) * 64 + F.lane] = a2; part[(F.wave * 5 + 3) * 64 + F.lane] = a3; part[(F.wave * 5 + 4) * 64 + F.lane] = a4;
        __syncthreads();
        if (F.tid < 320) { const int r = F.tid >> 6, ln = F.tid & 63; float s = p.in[I_BMOD][l * NMODC + cb * 64 + ln];
#pragma unroll
            for (int w = 0; w < 8; ++w) s += part[(w * 5 + r) * 64 + ln];
            mod[(size_t)(l * 5 + r) * NMODC + cb * 64 + ln] = s; }
        __syncthreads();
    }
    const f32x4* xs = (const f32x4*)p.in[I_X]; f32x4* xd = (f32x4*)p.out;
    for (size_t i = (size_t)F.bid * 512 + F.tid; i < (size_t)TL * D / 4; i += (size_t)F.nblk * 512) xd[i] = xs[i];
    const f32x4* cs = (const f32x4*)p.in[I_CTX]; f32x4* cd = (f32x4*)(p.ws + WS_XCTX);
    for (size_t i = (size_t)F.bid * 512 + F.tid; i < (size_t)TC * D / 4; i += (size_t)F.nblk * 512) cd[i] = cs[i];
}
__device__ __forceinline__ void nm_rows(const Params& p, const Frame& F, const float* mod, const float* g, int lo, int hi, int pns, const float* pgate, float pcoef) {
    bf16_t* hA = (bf16_t*)(p.ws + WS_HA);
    f32x4 gs[4], sh[4]; int curmr = -1;
    for (int r = lo; r < hi; r += 4) {
        f32x4 v[4][4];
#pragma unroll
        for (int k = 0; k < 4; ++k) { const int rr = r + k < hi ? r + k : hi - 1; const float* xr = xrow_of(p, rr);
#pragma unroll
            for (int j = 0; j < 4; ++j) v[k][j] = *(const f32x4*)(xr + 4 * F.lane + 256 * j); }
        if (pns > 0) {
            const float* part = (const float*)(p.ws + WS_U);
#pragma unroll
            for (int k = 0; k < 4; ++k) { const int rr = r + k; if (rr < hi) { const int rc = rr - TL, pmq = rc >> 8, rit = rc & 255; float* xr = xrow_of(p, rr);
                if (pns == 11) {
#pragma unroll
                    for (int j2 = 0; j2 < 4; j2 += 2) { f32x4 pv[2][11];
#pragma unroll
                        for (int jj = 0; jj < 2; ++jj) { const float* pp = part + (size_t)((pmq * 4 + j2 + jj) * 11) * 65536 + (size_t)rit * 256 + 4 * F.lane;
#pragma unroll
                            for (int sl = 0; sl < 11; ++sl) pv[jj][sl] = *(const f32x4*)(pp + (size_t)sl * 65536); }
#pragma unroll
                        for (int jj = 0; jj < 2; ++jj) { const int j = j2 + jj; f32x4 s4 = {0.f, 0.f, 0.f, 0.f};
#pragma unroll
                            for (int sl = 0; sl < 11; ++sl) s4 += pv[jj][sl];
                            v[k][j] += *(const f32x4*)(pgate + 4 * F.lane + 256 * j) * pcoef * s4; *(f32x4*)(xr + 4 * F.lane + 256 * j) = v[k][j]; } }
                } else {
                    f32x4 pv[4][4];
#pragma unroll
                    for (int j = 0; j < 4; ++j) { const float* pp = part + (size_t)((pmq * 4 + j) * pns) * 65536 + (size_t)rit * 256 + 4 * F.lane;
#pragma unroll
                        for (int sl = 0; sl < 4; ++sl) pv[j][sl] = sl < pns ? *(const f32x4*)(pp + (size_t)sl * 65536) : (f32x4){0.f, 0.f, 0.f, 0.f}; }
#pragma unroll
                    for (int j = 0; j < 4; ++j) { const f32x4 s4 = (pv[j][0] + pv[j][1]) + (pv[j][2] + pv[j][3]);
                        v[k][j] += *(const f32x4*)(pgate + 4 * F.lane + 256 * j) * pcoef * s4; *(f32x4*)(xr + 4 * F.lane + 256 * j) = v[k][j]; }
                } } }
        }
#pragma unroll
        for (int k = 0; k < 4; ++k) { const int rr = r + k; if (rr < hi) {
            const int mr = modrow_of(rr);
            if (mr != curmr) { curmr = mr; const float* shp = mod + (size_t)mr * NMODC;
#pragma unroll
                for (int j = 0; j < 4; ++j) { sh[j] = *(const f32x4*)(shp + 4 * F.lane + 256 * j); gs[j] = (*(const f32x4*)(shp + D + 4 * F.lane + 256 * j) + 1.0f) * *(const f32x4*)(g + 4 * F.lane + 256 * j); } }
            float ss = 0.f;
#pragma unroll
            for (int j = 0; j < 4; ++j) ss += (v[k][j].x * v[k][j].x + v[k][j].y * v[k][j].y) + (v[k][j].z * v[k][j].z + v[k][j].w * v[k][j].w);
            const float rstd = 1.0f / sqrtf(wave_sum(ss) * (1.0f / D) + 1e-6f);
#pragma unroll
            for (int j = 0; j < 4; ++j) { const f32x4 o = v[k][j] * rstd * gs[j] + sh[j];
                u32x2 w; w.x = cvt_pk_bf16(o.x, o.y); w.y = cvt_pk_bf16(o.z, o.w); *(u32x2*)(hA + (size_t)rr * D + 4 * F.lane + 256 * j) = w; } } }
    }
}
__device__ __forceinline__ void phase_normmod(const Params& p, const Frame& F, int l, int which, int nrows, int pns, const float* pgate, float pcoef) {
    const float* mod = (const float*)(p.ws + WS_MOD) + (size_t)(l * 5) * NMODC + (3 * which) * D;
    const float* g = p.in[I_NORMG] + (size_t)(l * 3 + which) * D;
    const int nw = F.nblk * 8, gw = F.bid * 8 + F.wave;
    nm_rows(p, F, mod, g, (int)(((long)gw * TL) / nw), (int)(((long)(gw + 1) * TL) / nw), 0, pgate, pcoef);
    if (nrows == T) nm_rows(p, F, mod, g, TL + (int)(((long)gw * TC) / nw), TL + (int)(((long)(gw + 1) * TC) / nw), pns, pgate, pcoef);
}
#define XB_TMO      128
#define XB_XCNT(j)  (256  + 64 * (j))
#define XB_XSUB(j)  (1280 + 64 * (j))
#define XB_XGEN(j)  (2304 + 64 * (j))
#define XB_TOP      3328
#define XB_TOPGEN   3392
#define XCD_BAR_WORDS 3456
#define XB_SPIN_CAP (1u << 18)

__device__ __forceinline__ unsigned xb_ld(unsigned* p)              { return __hip_atomic_load(p, __ATOMIC_RELAXED, __HIP_MEMORY_SCOPE_AGENT); }
__device__ __forceinline__ unsigned xb_add(unsigned* p, unsigned v) { return __hip_atomic_fetch_add(p, v, __ATOMIC_RELAXED, __HIP_MEMORY_SCOPE_AGENT); }
__device__ __forceinline__ unsigned xb_xcc_id() { return (unsigned)__builtin_amdgcn_s_getreg((3 << 11) | 20) & 0xFu; }
#define XB_SPIN(cond, bar) do { unsigned _sp = 0; while (cond) { __builtin_amdgcn_s_sleep(1); \
    if ((++_sp & 255u) == 0u) { if (xb_ld(&(bar)[XB_TMO])) break; if (_sp > XB_SPIN_CAP) { atomicAdd(&(bar)[XB_TMO], 1u); break; } } } } while (0)

struct XcdBarrier {
    unsigned* bar; unsigned x;
    volatile LAS unsigned* st;
};

__device__ __forceinline__ XcdBarrier xcd_barrier_post(unsigned* bar, volatile LAS unsigned* st) {
    XcdBarrier b; b.bar = bar; b.x = xb_xcc_id(); b.st = st;
    if (threadIdx.x == 0) (void)xb_add(&bar[XB_XCNT(b.x)], 1u);
    return b;
}
__device__ __forceinline__ void xcd_barrier_complete(unsigned* bar, unsigned x, unsigned& nloc, unsigned& nx) {
    const unsigned G = gridDim.x * gridDim.y * gridDim.z;
    unsigned sum, cnt, mine, sp = 0u;
    for (;;) {
        sum = 0u; cnt = 0u; mine = 0u;
#pragma unroll
        for (unsigned j = 0; j < 16; ++j) { const unsigned c = xb_ld(&bar[XB_XCNT(j)]); sum += c; cnt += (c > 0u) ? 1u : 0u; mine = (j == x) ? c : mine; }
        if (sum == G) break;
        __builtin_amdgcn_s_sleep(1);
        if ((++sp & 255u) == 0u) { if (xb_ld(&bar[XB_TMO])) break; if (sp > XB_SPIN_CAP) { atomicAdd(&bar[XB_TMO], 1u); break; } }
    }
    nloc = mine > 0u ? mine : 1u; nx = cnt > 0u ? cnt : 1u;
}

__device__ __forceinline__ void xcd_barrier(const XcdBarrier& b) {
    asm volatile("s_waitcnt vmcnt(0)" ::: "memory");
    __syncthreads();
    if (threadIdx.x == 0) {
        unsigned* bar = b.bar;
        __builtin_amdgcn_s_waitcnt(0);
        unsigned nloc = b.st[0], nx = b.st[1];
        if (nloc == 0u) { xcd_barrier_complete(bar, b.x, nloc, nx); b.st[0] = nloc; b.st[1] = nx; }
        const unsigned old = xb_add(&bar[XB_XSUB(b.x)], 1u);
        const unsigned gen = old / nloc;
        if (old + 1u == (gen + 1u) * nloc) {
            __builtin_amdgcn_fence(__ATOMIC_RELEASE, "agent");
            asm volatile("s_waitcnt vmcnt(0)" ::: "memory");
            const unsigned og = xb_add(&bar[XB_TOP], 1u);
            const unsigned tg = og / nx;
            if (og + 1u == (tg + 1u) * nx) xb_add(&bar[XB_TOPGEN], 1u);
            else XB_SPIN(xb_ld(&bar[XB_TOPGEN]) == tg, bar);
            __builtin_amdgcn_fence(__ATOMIC_ACQUIRE, "agent");
            xb_add(&bar[XB_XGEN(b.x)], 1u);
            asm volatile("s_waitcnt vmcnt(0)" ::: "memory");
        } else {
            XB_SPIN(xb_ld(&bar[XB_XGEN(b.x)]) == gen, bar);
            __builtin_amdgcn_fence(__ATOMIC_ACQUIRE, "agent");
            asm volatile("s_waitcnt vmcnt(0)" ::: "memory");
        }
    }
    __syncthreads();
}
constexpr int U_GLA_Q = 0, U_GLA_K = 128, U_GLA_V = 256, U_GLA_G = 512, U_GLA_LR = 768;
constexpr int U_SSM_Z = 784, U_SSM_XBC = 1040, U_SSM_DT = 1552;
constexpr int U_RW = 1556;
constexpr int U_ATT_Q = 2580, U_ATT_K = 2836, U_ATT_V = 2964;

__device__ __forceinline__ void phase_prep(const Params& p, const Frame& F, int l) {
    const bf16_t* U = (const bf16_t*)(p.ws + WS_U);
    const size_t gtid = (size_t)F.bid * 512 + F.tid, gstride = (size_t)F.nblk * 512;
    { float* dec = (float*)(p.ws + WS_DEC); const float* wdec = p.in[I_GLA_WDEC] + (size_t)l * 2 * 16 * 128; const float* bdec = p.in[I_GLA_BDEC] + (size_t)l * 2 * 128;
      const int dc = (int)(gtid & 255), d = dc >> 7, c = dc & 127, tstep = (int)(gstride >> 8);
      float wv[16];
#pragma unroll
      for (int k = 0; k < 16; ++k) wv[k] = wdec[(d * 16 + k) * 128 + c];
      const float bz = bdec[d * 128 + c];
      for (int t = (int)(gtid >> 8); t < T; t += 4 * tstep) {
          u32x4 l0[4], l1[4];
#pragma unroll
          for (int k4 = 0; k4 < 4; ++k4) { const int tt = t + k4 * tstep; if (tt < T) { const bf16_t* lr = U + (size_t)tt * NINP + U_GLA_LR; l0[k4] = *(const u32x4*)lr; l1[k4] = *(const u32x4*)(lr + 8); } else { l0[k4] = (u32x4){0u, 0u, 0u, 0u}; l1[k4] = l0[k4]; } }
#pragma unroll
          for (int k4 = 0; k4 < 4; ++k4) { const int tt = t + k4 * tstep; if (tt < T) { float z = bz;
#pragma unroll
              for (int k = 0; k < 4; ++k) { z += __uint_as_float(l0[k4][k] << 16) * wv[2 * k] + __uint_as_float(l0[k4][k] & 0xffff0000u) * wv[2 * k + 1]; z += __uint_as_float(l1[k4][k] << 16) * wv[8 + 2 * k] + __uint_as_float(l1[k4][k] & 0xffff0000u) * wv[8 + 2 * k + 1]; }
              dec[(size_t)tt * 256 + dc] = __expf(-__logf(1.0f + __expf(-z)) * (1.0f / 16.0f)); } }
      } }
    { float* xbc = (float*)(p.ws + WS_XBC); const float* cw = p.in[I_SSM_CONVW] + (size_t)l * 3 * 512; const float* cb = p.in[I_SSM_CONVB] + (size_t)l * 512;
      { const int ch = (int)(gtid & 511), tstep = (int)(gstride >> 9); const float w0c = cw[ch], w1c = cw[512 + ch], w2c = cw[1024 + ch], bc = cb[ch];
        for (int t = (int)(gtid >> 9); t < T; t += 8 * tstep) {
            float cv[8], pv[8], nv[8];
#pragma unroll
            for (int k = 0; k < 8; ++k) { const int tt = t + k * tstep; cv[k] = 0.f; pv[k] = 0.f; nv[k] = 0.f;
                if (tt < T) { int pos, len; seq_of(tt, pos, len); const bf16_t* ur = U + (size_t)tt * NINP + U_SSM_XBC + ch; cv[k] = bf2f(ur[0]); if (pos > 0) pv[k] = bf2f(ur[-NINP]); if (pos < len - 1) nv[k] = bf2f(ur[NINP]); } }
#pragma unroll
            for (int k = 0; k < 8; ++k) { const int tt = t + k * tstep; if (tt < T) xbc[(size_t)tt * 512 + ch] = silu_fast2(bc + w1c * cv[k] + w0c * pv[k] + w2c * nv[k]); }
        } }
      float* dtb = (float*)(p.ws + WS_DT); const float* bias = p.in[I_SSM_DTB] + l * 8; const float* alog = p.in[I_SSM_ALOG] + l * 8;
      for (size_t i = gtid; i < (size_t)T * 8; i += gstride) { const int t = (int)(i >> 3), dh = (int)(i & 7), h = dh & 3;
          const float dtv = softplus_f(bf2f(U[(size_t)t * NINP + U_SSM_DT + h]) + bias[dh]);
          dtb[(size_t)t * 16 + dh] = dtv; dtb[(size_t)t * 16 + 8 + dh] = expf(-dtv * expf(alog[dh])); } }
    { bf16_t* aq = (bf16_t*)(p.ws + WS_ATTQ); bf16_t* ak = (bf16_t*)(p.ws + WS_ATTK); bf16_t* avt = (bf16_t*)(p.ws + WS_ATTVT);
      const float qn = p.in[I_ATT_QN][l * 64 + F.lane], kn = p.in[I_ATT_KN][l * 64 + F.lane];
      const int dd = F.lane, axis = dd >> 5, half = (dd >> 4) & 1, fi = dd & 15;
      const float inv = exp2f(-(float)fi * 0.8304820237218406f);
#ifndef REP_D
#define REP_D 1
#endif
      for (int rep_d = 0; rep_d < REP_D; ++rep_d)
      for (int t = F.bid * 8 + F.wave; t < T; t += F.nblk * 8) {
          const bf16_t* ur = U + (size_t)t * NINP; const bool lat = t < TL; int pos, len; seq_of(t, pos, len);
          const int b = lat ? (t >> 12) : ((t - TL) >> 8); const int key = lat ? pos : SEQ + pos;
          float cs = 1.f, sn = 0.f;
          if (lat) { const float ang = (float)(axis == 0 ? (pos >> 6) : (pos & 63)) * inv; const float kq = rintf(ang * 0.15915494309189535f);
              float rr = fmaf(-kq, 6.28125f, ang); rr = fmaf(-kq, 1.9353071795864769e-3f, rr); cs = cosf(rr); sn = sinf(rr); }
          bf16_t raw[8];
#pragma unroll
          for (int hh = 0; hh < 8; ++hh) raw[hh] = ur[U_ATT_Q + hh * 64 + dd];
#pragma unroll
          for (int hh = 0; hh < 6; ++hh) {
              const float v = bf2f(raw[hh]);
              const float ss = wave_sum(v * v); float n = v * (1.0f / sqrtf(ss * (1.0f / 64.0f) + 1e-6f)) * (hh < 4 ? qn : kn);
              const float pr = __shfl_xor(n, 16);
              n = n * cs + (half ? pr * sn : -pr * sn);
              if (hh < 4) { aq[(size_t)t * 256 + hh * 64 + dd] = (bf16_t)(cvt_pk_bf16(n * 0.18033688011112042f, 0.f) & 0xffffu); }
              else { ak[((size_t)(b * 2 + (hh - 4)) * NKEY + key) * 64 + dd] = (bf16_t)(cvt_pk_bf16(n, 0.f) & 0xffffu); }
          }
#pragma unroll
          for (int hh = 0; hh < 2; ++hh) { avt[((size_t)(b * 2 + hh) * 64 + dd) * NKEY + key] = raw[6 + hh]; }
      } }
    { float* S = (float*)(p.ws + WS_RW); float* G = (float*)(p.ws + WS_G);
      const float* mu0 = p.in[I_RW_MU] + (size_t)l * 2 * 1024; const float* mu1 = mu0 + 1024;
      const float* w0 = p.in[I_RW_W0] + (size_t)l * 2 * 256; const float* wdec = p.in[I_RW_WDEC] + (size_t)l * 2 * 64 * 256;
      const float* wa = p.in[I_RW_WA] + (size_t)l * 64 * 256; const float* wg = p.in[I_RW_WG] + (size_t)l * 128 * 256;
      LAS unsigned char* WT = F.lds;
      LAS unsigned char* inb = F.lds + 110592;
      LAS float* red = (LAS float*)(F.lds + 110592 + 4352);
      const int lr = F.lane & 15, lq = F.lane >> 4, hh = F.wave >> 1;
#ifndef REP_C
#define REP_C 1
#endif
      for (int rep_c = 0; rep_c < REP_C; ++rep_c) {
      __syncthreads();
      for (int idx = F.tid; idx < 3 * 32 * 256; idx += 512) { const int q = idx / 8192, rem = idx % 8192, kp = rem >> 8, n = rem & 255; const float* src = q == 0 ? wa : (q == 1 ? wdec : wdec + 64 * 256);
          *(LAS unsigned*)(WT + q * 36864 + n * 144 + kp * 4) = cvt_pk_bf16(src[(2 * kp) * 256 + n], src[(2 * kp + 1) * 256 + n]); }
      float a0c[2], kkc[2], kac[2], w00[2], w01[2], m0r[2], m1r[2], m0k[2], m1k[2], m0v[2], m1v[2];
#pragma unroll
      for (int jt = 0; jt < 2; ++jt) { const int c = 32 * F.wave + 16 * jt + lr;
          a0c[jt] = p.in[I_RW_A0][l * 256 + c]; kkc[jt] = p.in[I_RW_KK][l * 256 + c]; kac[jt] = p.in[I_RW_KA][l * 256 + c]; w00[jt] = w0[c]; w01[jt] = w0[256 + c];
          m0r[jt] = mu0[c]; m1r[jt] = mu1[c]; m0k[jt] = mu0[256 + c]; m1k[jt] = mu1[256 + c]; m0v[jt] = mu0[512 + c]; m1v[jt] = mu1[512 + c]; }
      __syncthreads();
      for (int tile = F.bid; tile < T / 16; tile += F.nblk) {
          const int r0 = tile * 16;
          { float cv[4], pv[4], nv[4];
#pragma unroll
            for (int k = 0; k < 4; ++k) { const int idx = F.tid + 512 * k, tt = idx >> 7, ci = 768 + (idx & 127), r = r0 + tt; int pos, len; seq_of(r, pos, len);
                const bf16_t* ur = U + (size_t)r * NINP + U_RW + ci; cv[k] = bf2f(ur[0]); pv[k] = pos > 0 ? bf2f(ur[-NINP]) : 0.f; nv[k] = pos < len - 1 ? bf2f(ur[NINP]) : 0.f; }
#pragma unroll
            for (int k = 0; k < 4; ++k) { const int idx = F.tid + 512 * k, tt = idx >> 7, cj = idx & 127, ci = 768 + cj; float val = cv[k] + mu0[ci] * (pv[k] - cv[k]) + mu1[ci] * (nv[k] - cv[k]); if (cj < 64) val = 1.0f - 2.0f * __builtin_amdgcn_rcpf(1.0f + __expf(2.0f * val));
                *(LAS bf16_t*)(inb + tt * 272 + cj * 2) = (bf16_t)(cvt_pk_bf16(val, 0.f) & 0xffffu); } }
          __syncthreads();
          f32x4 acc[3][2];
          { bf16x8 alw[2], ala[2];
#pragma unroll
            for (int s2 = 0; s2 < 2; ++s2) { alw[s2] = *(const LAS bf16x8*)(inb + lr * 272 + 64 * s2 + 16 * lq); ala[s2] = *(const LAS bf16x8*)(inb + lr * 272 + 128 + 64 * s2 + 16 * lq); }
#pragma unroll
            for (int q = 0; q < 3; ++q)
#pragma unroll
                for (int jt = 0; jt < 2; ++jt) { acc[q][jt] = (f32x4){0.f, 0.f, 0.f, 0.f};
#pragma unroll
                    for (int s2 = 0; s2 < 2; ++s2) { const bf16x8 bw = *(const LAS bf16x8*)(WT + q * 36864 + (32 * F.wave + 16 * jt + lr) * 144 + 64 * s2 + 16 * lq);
                        acc[q][jt] = __builtin_amdgcn_mfma_f32_16x16x32_bf16(q == 0 ? ala[s2] : alw[s2], bw, acc[q][jt], 0, 0, 0); } } }
          float rrv[2][4], krv[2][4], vvv[2][4], kkr[2][4], ssp[4];
#pragma unroll
          for (int i = 0; i < 4; ++i) ssp[i] = 0.f;
#pragma unroll
          for (int jt = 0; jt < 2; ++jt) { const int c = 32 * F.wave + 16 * jt + lr;
              float cr[4], pr[4], nr[4], ck[4], pk[4], nk[4], cvv[4], pvv[4], nvv[4];
#pragma unroll
              for (int i = 0; i < 4; ++i) { const int r = r0 + 4 * lq + i; int pos, len; seq_of(r, pos, len); const bf16_t* ur = U + (size_t)r * NINP + U_RW + c; const bool hp = pos > 0, hn = pos < len - 1;
                  cr[i] = bf2f(ur[0]); ck[i] = bf2f(ur[256]); cvv[i] = bf2f(ur[512]);
                  pr[i] = hp ? bf2f(ur[-NINP]) : 0.f; pk[i] = hp ? bf2f(ur[256 - NINP]) : 0.f; pvv[i] = hp ? bf2f(ur[512 - NINP]) : 0.f;
                  nr[i] = hn ? bf2f(ur[NINP]) : 0.f; nk[i] = hn ? bf2f(ur[256 + NINP]) : 0.f; nvv[i] = hn ? bf2f(ur[512 + NINP]) : 0.f; }
#pragma unroll
              for (int i = 0; i < 4; ++i) { rrv[jt][i] = cr[i] + m0r[jt] * (pr[i] - cr[i]) + m1r[jt] * (nr[i] - cr[i]); krv[jt][i] = ck[i] + m0k[jt] * (pk[i] - ck[i]) + m1k[jt] * (nk[i] - ck[i]); vvv[jt][i] = cvv[i] + m0v[jt] * (pvv[i] - cvv[i]) + m1v[jt] * (nvv[i] - cvv[i]);
                  kkr[jt][i] = krv[jt][i] * kkc[jt]; ssp[i] += kkr[jt][i] * kkr[jt][i]; } }
#pragma unroll
          for (int i = 0; i < 4; ++i) { ssp[i] = sum16(ssp[i]); if (lr == 0) red[(4 * lq + i) * 8 + F.wave] = ssp[i]; }
          __syncthreads();
#pragma unroll
          for (int i = 0; i < 4; ++i) { const int tt = 4 * lq + i, r = r0 + tt; const float ss = red[tt * 8 + F.wave] + red[tt * 8 + (F.wave ^ 1)]; const float rn = 1.0f / fmaxf(sqrtf(ss), 1e-12f);
#pragma unroll
              for (int jt = 0; jt < 2; ++jt) { const int c = 32 * F.wave + 16 * jt + lr;
                  const float a = 1.0f / (1.0f + __expf(-(a0c[jt] + acc[0][jt][i]))); const float kk = kkr[jt][i] * rn;
                  const float k2 = krv[jt][i] * (1.0f + (a - 1.0f) * kac[jt]);
                  const float wv0 = __expf(-0.6065306597126334f / (1.0f + __expf(-(w00[jt] + acc[1][jt][i])))), wv1 = __expf(-0.6065306597126334f / (1.0f + __expf(-(w01[jt] + acc[2][jt][i]))));
                  float* sp = S + ((size_t)r * 4 + hh) * 448 + (c & 63);
                  sp[0] = rrv[jt][i]; sp[64] = wv0; sp[128] = wv1; sp[192] = k2; sp[256] = -kk; sp[320] = kk * a; sp[384] = vvv[jt][i]; } }
          __syncthreads();
      }
      for (int idx = F.tid; idx < 64 * 256; idx += 512) { const int kp = idx >> 8, n = idx & 255; *(LAS unsigned*)(WT + n * 272 + kp * 4) = cvt_pk_bf16(wg[(2 * kp) * 256 + n], wg[(2 * kp + 1) * 256 + n]); }
      __syncthreads();
      for (int tile = F.bid; tile < T / 16; tile += F.nblk) {
          const int r0 = tile * 16;
          { float cv[4], pv[4], nv[4];
#pragma unroll
            for (int k = 0; k < 4; ++k) { const int idx = F.tid + 512 * k, tt = idx >> 7, ci = 896 + (idx & 127), r = r0 + tt; int pos, len; seq_of(r, pos, len);
                const bf16_t* ur = U + (size_t)r * NINP + U_RW + ci; cv[k] = bf2f(ur[0]); pv[k] = pos > 0 ? bf2f(ur[-NINP]) : 0.f; nv[k] = pos < len - 1 ? bf2f(ur[NINP]) : 0.f; }
#pragma unroll
            for (int k = 0; k < 4; ++k) { const int idx = F.tid + 512 * k, tt = idx >> 7, cj = idx & 127, ci = 896 + cj; const float val = sigmoid_fast(cv[k] + mu0[ci] * (pv[k] - cv[k]) + mu1[ci] * (nv[k] - cv[k]));
                *(LAS bf16_t*)(inb + tt * 272 + cj * 2) = (bf16_t)(cvt_pk_bf16(val, 0.f) & 0xffffu); } }
          __syncthreads();
          f32x4 ag[2];
          { bf16x8 alg[4];
#pragma unroll
            for (int s4 = 0; s4 < 4; ++s4) alg[s4] = *(const LAS bf16x8*)(inb + lr * 272 + 64 * s4 + 16 * lq);
#pragma unroll
            for (int jt = 0; jt < 2; ++jt) { ag[jt] = (f32x4){0.f, 0.f, 0.f, 0.f};
#pragma unroll
                for (int s4 = 0; s4 < 4; ++s4) { const bf16x8 bw = *(const LAS bf16x8*)(WT + (32 * F.wave + 16 * jt + lr) * 272 + 64 * s4 + 16 * lq); ag[jt] = __builtin_amdgcn_mfma_f32_16x16x32_bf16(alg[s4], bw, ag[jt], 0, 0, 0); } } }
#pragma unroll
          for (int jt = 0; jt < 2; ++jt)
#pragma unroll
              for (int i = 0; i < 4; ++i) G[(size_t)(r0 + 4 * lq + i) * 256 + 32 * F.wave + 16 * jt + lr] = ag[jt][i];
          __syncthreads();
      }
      }
    }
}
__device__ __forceinline__ int seg_r0(int b, int dir, int pp) { return pp < 4 ? TL + b * CTXL + (dir ? 3 - pp : pp) * 64 : b * SEQ + (dir ? 63 - (pp - 4) : pp - 4) * 64; }
typedef float f32x2v __attribute__((ext_vector_type(2)));
#define MEMFENCE() asm volatile("" ::: "memory")

__device__ __forceinline__ void rwkv_pass1(const Params& p, const Frame& F, int ci, int pp, LAS float* wl) {
    int lane = F.lane; asm volatile("" : "+v"(lane));
    const int b = ci >> 3, h = (ci >> 1) & 3, dir = ci & 1, r0 = seg_r0(b, dir, pp);
    const float* S = (const float*)(p.ws + WS_RW);
    float* Y = (float*)(p.ws + (dir ? WS_Y2 : WS_Y)) + (size_t)2 * T * 256; float* Z = (float*)(p.ws + WS_ZRW) + (size_t)dir * T * 256;
    f32x2v sE[32], sP[32];
#pragma unroll
    for (int j = 0; j < 32; ++j) { sE[j] = (f32x2v){0.f, 0.f}; sP[j] = (f32x2v){(2 * j == lane) ? 1.f : 0.f, (2 * j + 1 == lane) ? 1.f : 0.f}; }
    float pre[4][7];
#pragma unroll
    for (int s4 = 0; s4 < 4; ++s4) { const int row = r0 + (dir ? 63 - s4 : s4); const float* base = S + ((size_t)row * 4 + h) * 448 + lane;
#pragma unroll
        for (int q = 0; q < 7; ++q) pre[s4][q] = base[q * 64]; }
    for (int n0 = 0; n0 < 64; n0 += 4) {
        MEMFENCE();
#pragma unroll
        for (int s4 = 0; s4 < 4; ++s4)
#pragma unroll
            for (int q = 0; q < 7; ++q) wl[s4 * 448 + q * 64 + lane] = pre[s4][q];
        MEMFENCE();
        if (n0 + 4 < 64) {
#pragma unroll
            for (int s4 = 0; s4 < 4; ++s4) { const int row = r0 + (dir ? 63 - (n0 + 4 + s4) : n0 + 4 + s4); const float* base = S + ((size_t)row * 4 + h) * 448 + lane;
#pragma unroll
                for (int q = 0; q < 7; ++q) pre[s4][q] = base[q * 64]; }
        }
#pragma unroll 1
        for (int s4 = 0; s4 < 4; ++s4) {
            const LAS float* o = wl + s4 * 448; const LAS float* pw = o + 64 * (1 + dir);
            const int row = r0 + (dir ? 63 - (n0 + s4) : n0 + s4);
            const float v = o[384 + lane];
            f32x2v aE0 = {0.f, 0.f}, aE1 = {0.f, 0.f}, aP0 = {0.f, 0.f}, aP1 = {0.f, 0.f};
            f32x4 av[16], wv[16], bv[16], kv[16], rv[16];
#pragma unroll
            for (int q = 0; q < 4; ++q) av[q] = *(const LAS f32x4*)(o + 256 + 4 * q);
#pragma unroll
            for (int jj = 0; jj < 16; ++jj) {
                if (jj + 4 < 16) av[jj + 4] = *(const LAS f32x4*)(o + 256 + 4 * (jj + 4));
                else if (jj + 4 < 18) { const int q = jj + 4 - 16; wv[q] = *(const LAS f32x4*)(pw + 4 * q); bv[q] = *(const LAS f32x4*)(o + 320 + 4 * q); kv[q] = *(const LAS f32x4*)(o + 192 + 4 * q); rv[q] = *(const LAS f32x4*)(o + 4 * q); }
                MEMFENCE();
                const f32x2v alo = {av[jj].x, av[jj].y}, ahi = {av[jj].z, av[jj].w};
                aE0 += sE[2 * jj] * alo; aE1 += sE[2 * jj + 1] * ahi; aP0 += sP[2 * jj] * alo; aP1 += sP[2 * jj + 1] * ahi; }
            const float saE = (aE0.x + aE0.y) + (aE1.x + aE1.y), saP = (aP0.x + aP0.y) + (aP1.x + aP1.y);
            const f32x2v saE2 = {saE, saE}, saP2 = {saP, saP}, v2 = {v, v};
            f32x2v yE0 = {0.f, 0.f}, yE1 = {0.f, 0.f}, zP0 = {0.f, 0.f}, zP1 = {0.f, 0.f};
#pragma unroll
            for (int jj = 0; jj < 16; ++jj) {
                if (jj + 2 < 16) { const int q = jj + 2; wv[q] = *(const LAS f32x4*)(pw + 4 * q); bv[q] = *(const LAS f32x4*)(o + 320 + 4 * q); kv[q] = *(const LAS f32x4*)(o + 192 + 4 * q); rv[q] = *(const LAS f32x4*)(o + 4 * q); }
                MEMFENCE();
                const f32x4 w4 = wv[jj], b4 = bv[jj], k4 = kv[jj], r4 = rv[jj];
                const f32x2v wlo = {w4.x, w4.y}, whi = {w4.z, w4.w}, blo = {b4.x, b4.y}, bhi = {b4.z, b4.w}, klo = {k4.x, k4.y}, khi = {k4.z, k4.w}, rlo = {r4.x, r4.y}, rhi = {r4.z, r4.w};
                sE[2 * jj] = sE[2 * jj] * wlo + saE2 * blo + v2 * klo; sE[2 * jj + 1] = sE[2 * jj + 1] * whi + saE2 * bhi + v2 * khi;
                sP[2 * jj] = sP[2 * jj] * wlo + saP2 * blo; sP[2 * jj + 1] = sP[2 * jj + 1] * whi + saP2 * bhi;
                yE0 += sE[2 * jj] * rlo; yE1 += sE[2 * jj + 1] * rhi; zP0 += sP[2 * jj] * rlo; zP1 += sP[2 * jj + 1] * rhi; }
            Y[(size_t)row * 256 + h * 64 + lane] = (yE0.x + yE0.y) + (yE1.x + yE1.y);
            Z[(size_t)row * 256 + h * 64 + lane] = (zP0.x + zP0.y) + (zP1.x + zP1.y);
        }
    }
    float* E = (float*)(p.ws + WS_RWE) + ((size_t)(ci * NSEG + pp) * 64 + lane) * 64; float* P = (float*)(p.ws + WS_RWP) + ((size_t)(ci * NSEG + pp) * 64 + lane) * 64;
#pragma unroll
    for (int jj = 0; jj < 16; ++jj) { *(f32x4*)(E + 4 * jj) = (f32x4){sE[2 * jj].x, sE[2 * jj].y, sE[2 * jj + 1].x, sE[2 * jj + 1].y}; *(f32x4*)(P + 4 * jj) = (f32x4){sP[2 * jj].x, sP[2 * jj].y, sP[2 * jj + 1].x, sP[2 * jj + 1].y}; }
}
__device__ __forceinline__ void ssd_pass1(const Params& p, const Frame& F, int ci, int pp, LAS float* wl) {
    int lane = F.lane; asm volatile("" : "+v"(lane));
    const int b = ci >> 3, h = (ci >> 1) & 3, dir = ci & 1, r0 = seg_r0(b, dir, pp), g = h >> 1;
    const float* XBC = (const float*)(p.ws + WS_XBC); const float* DT = (const float*)(p.ws + WS_DT);
    float* Y = (float*)(p.ws + (dir ? WS_Y2 : WS_Y)) + (size_t)T * 256; float* Z = (float*)(p.ws + WS_ZSS) + (size_t)dir * T * 256;
    LAS unsigned char* wb = (LAS unsigned char*)wl;
    f32x2v hs[32];
#pragma unroll
    for (int j = 0; j < 32; ++j) hs[j] = (f32x2v){0.f, 0.f};
    float cum = 1.f;
    float pre[8][4];
#pragma unroll
    for (int s8 = 0; s8 < 8; ++s8) { const int row = r0 + (dir ? 63 - s8 : s8); const float* xb = XBC + (size_t)row * 512;
        pre[s8][0] = xb[256 + g * 64 + lane]; pre[s8][1] = xb[384 + g * 64 + lane]; pre[s8][2] = xb[h * 64 + lane]; pre[s8][3] = DT[(size_t)row * 16 + dir * 4 + h + ((lane & 1) ? 8 : 0)]; }
    for (int n0 = 0; n0 < 64; n0 += 8) {
        MEMFENCE();
#pragma unroll
        for (int s8 = 0; s8 < 8; ++s8) { LAS unsigned char* o = wb + s8 * 528;
            *(LAS bf16_t*)(o + lane * 2) = (bf16_t)(cvt_pk_bf16(pre[s8][0], 0.f) & 0xffffu); *(LAS bf16_t*)(o + 128 + lane * 2) = (bf16_t)(cvt_pk_bf16(pre[s8][1], 0.f) & 0xffffu);
            *(LAS float*)(o + 256 + lane * 4) = pre[s8][2]; if (lane < 2) *(LAS float*)(o + 512 + lane * 4) = pre[s8][3]; }
        MEMFENCE();
        if (n0 + 8 < 64) {
#pragma unroll
            for (int s8 = 0; s8 < 8; ++s8) { const int row = r0 + (dir ? 63 - (n0 + 8 + s8) : n0 + 8 + s8); const float* xb = XBC + (size_t)row * 512;
                pre[s8][0] = xb[256 + g * 64 + lane]; pre[s8][1] = xb[384 + g * 64 + lane]; pre[s8][2] = xb[h * 64 + lane]; pre[s8][3] = DT[(size_t)row * 16 + dir * 4 + h + ((lane & 1) ? 8 : 0)]; }
        }
#pragma unroll 1
        for (int s8 = 0; s8 < 8; ++s8) {
            const LAS unsigned char* o = wb + s8 * 528; const int row = r0 + (dir ? 63 - (n0 + s8) : n0 + s8);
            const float dt = *(const LAS float*)(o + 512), dA = *(const LAS float*)(o + 516), xdt = *(const LAS float*)(o + 256 + lane * 4) * dt, cl = bf2f(*(const LAS bf16_t*)(o + 128 + lane * 2));
            const f32x2v dA2 = {dA, dA}, x2 = {xdt, xdt};
            f32x2v y0 = {0.f, 0.f}, y1 = {0.f, 0.f};
            u32x4 bq[8], cq[8];
#pragma unroll
            for (int q = 0; q < 3; ++q) { bq[q] = *(const LAS u32x4*)(o + 16 * q); cq[q] = *(const LAS u32x4*)(o + 128 + 16 * q); }
#pragma unroll
            for (int j8 = 0; j8 < 8; ++j8) {
                if (j8 + 3 < 8) { bq[j8 + 3] = *(const LAS u32x4*)(o + 16 * (j8 + 3)); cq[j8 + 3] = *(const LAS u32x4*)(o + 128 + 16 * (j8 + 3)); }
                MEMFENCE();
#pragma unroll
                for (int e = 0; e < 4; ++e) { const unsigned ub = bq[j8][e], uc = cq[j8][e];
                    const f32x2v bv = {__uint_as_float(ub << 16), __uint_as_float(ub & 0xffff0000u)}, cv = {__uint_as_float(uc << 16), __uint_as_float(uc & 0xffff0000u)};
                    hs[4 * j8 + e] = hs[4 * j8 + e] * dA2 + x2 * bv; if (e & 1) y1 += hs[4 * j8 + e] * cv; else y0 += hs[4 * j8 + e] * cv; } }
            cum *= dA;
            Y[(size_t)row * 256 + h * 64 + lane] = (y0.x + y0.y) + (y1.x + y1.y);
            Z[(size_t)row * 256 + h * 64 + lane] = cl * cum;
        }
    }
    float* E = (float*)(p.ws + WS_SSE) + ((size_t)(ci * NSEG + pp) * 64 + lane) * 64;
#pragma unroll
    for (int jj = 0; jj < 16; ++jj) *(f32x4*)(E + 4 * jj) = (f32x4){hs[2 * jj].x, hs[2 * jj].y, hs[2 * jj + 1].x, hs[2 * jj + 1].y};
    if (lane == 0) ((float*)(p.ws + WS_SDEC))[ci * NSEG + pp] = cum;
}
__device__ __forceinline__ void gla_pass1(const Params& p, const Frame& F, int ci, int pp, LAS float* wl) {
    int lane = F.lane; asm volatile("" : "+v"(lane));
    const int b = ci >> 3, h = (ci >> 1) & 3, dir = ci & 1, r0 = seg_r0(b, dir, pp);
    const bf16_t* U = (const bf16_t*)(p.ws + WS_U); const float* DEC = (const float*)(p.ws + WS_DEC);
    float* Y = (float*)(p.ws + (dir ? WS_Y2 : WS_Y)); float* Z = (float*)(p.ws + WS_ZGL) + (size_t)dir * T * 128;
    LAS unsigned char* wb = (LAS unsigned char*)wl;
    const float scale = 0.17677669529663687f;
    f32x2v st[16];
#pragma unroll
    for (int j = 0; j < 16; ++j) st[j] = (f32x2v){0.f, 0.f};
    float Wl = 1.f;
    const int qkcol = lane < 32 ? U_GLA_Q + h * 32 + lane : U_GLA_K + h * 32 + (lane - 32);
    bf16_t preq[8]; float prea[8]; bf16_t prev_[8];
#pragma unroll
    for (int s8 = 0; s8 < 8; ++s8) { const int row = r0 + (dir ? 63 - s8 : s8); const bf16_t* ur = U + (size_t)row * NINP;
        preq[s8] = ur[qkcol]; prea[s8] = DEC[(size_t)row * 256 + dir * 128 + h * 32 + (lane & 31)]; prev_[s8] = ur[U_GLA_V + h * 64 + lane]; }
    for (int n0 = 0; n0 < 64; n0 += 8) {
        MEMFENCE();
#pragma unroll
        for (int s8 = 0; s8 < 8; ++s8) { LAS unsigned char* o = wb + s8 * 512; *(LAS bf16_t*)(o + lane * 2) = preq[s8]; if (lane < 32) *(LAS float*)(o + 128 + lane * 4) = prea[s8]; *(LAS float*)(o + 256 + lane * 4) = bf2f(prev_[s8]); }
        MEMFENCE();
        if (n0 + 8 < 64) {
#pragma unroll
            for (int s8 = 0; s8 < 8; ++s8) { const int row = r0 + (dir ? 63 - (n0 + 8 + s8) : n0 + 8 + s8); const bf16_t* ur = U + (size_t)row * NINP;
                preq[s8] = ur[qkcol]; prea[s8] = DEC[(size_t)row * 256 + dir * 128 + h * 32 + (lane & 31)]; prev_[s8] = ur[U_GLA_V + h * 64 + lane]; }
        }
#pragma unroll 1
        for (int s8 = 0; s8 < 8; ++s8) {
            const LAS unsigned char* o = wb + s8 * 512; const int row = r0 + (dir ? 63 - (n0 + s8) : n0 + s8);
            const float v = *(const LAS float*)(o + 256 + lane * 4), al = *(const LAS float*)(o + 128 + (lane & 31) * 4), ql = bf2f(*(const LAS bf16_t*)(o + (lane & 31) * 2));
            const f32x2v v2 = {v, v};
            f32x2v y0 = {0.f, 0.f}, y1 = {0.f, 0.f};
            u32x4 qq[4], kq[4]; f32x4 aq[8];
#pragma unroll
            for (int q = 0; q < 4; ++q) { qq[q] = *(const LAS u32x4*)(o + 16 * q); kq[q] = *(const LAS u32x4*)(o + 64 + 16 * q); aq[2 * q] = *(const LAS f32x4*)(o + 128 + 32 * q); aq[2 * q + 1] = *(const LAS f32x4*)(o + 128 + 32 * q + 16); }
            MEMFENCE();
#pragma unroll
            for (int j4 = 0; j4 < 4; ++j4)
#pragma unroll
                for (int e = 0; e < 4; ++e) { const unsigned uq = qq[j4][e], uk = kq[j4][e]; const f32x4 a4 = aq[2 * j4 + (e >> 1)];
                    const f32x2v qv = {__uint_as_float(uq << 16), __uint_as_float(uq & 0xffff0000u)}, kv = {__uint_as_float(uk << 16), __uint_as_float(uk & 0xffff0000u)};
                    const f32x2v av = (e & 1) ? (f32x2v){a4.z, a4.w} : (f32x2v){a4.x, a4.y};
                    st[4 * j4 + e] = st[4 * j4 + e] * av + v2 * kv; if (e & 1) y1 += st[4 * j4 + e] * qv; else y0 += st[4 * j4 + e] * qv; }
            Wl *= al;
            Y[(size_t)row * 256 + h * 64 + lane] = ((y0.x + y0.y) + (y1.x + y1.y)) * scale;
            if (lane < 32) Z[(size_t)row * 128 + h * 32 + lane] = scale * ql * Wl;
        }
    }
    float* E = (float*)(p.ws + WS_GLE) + (size_t)(ci * NSEG + pp) * 2048 + lane;
#pragma unroll
    for (int j = 0; j < 16; ++j) { E[(2 * j) * 64] = st[j].x; E[(2 * j + 1) * 64] = st[j].y; }
    if (lane < 32) ((float*)(p.ws + WS_GDEC))[(ci * NSEG + pp) * 32 + lane] = Wl;
}
__device__ __forceinline__ void phase_s1(const Params& p, const Frame& F, int mlo = 0, int mhi = 3) {
    LAS float* wl = (LAS float*)(F.lds + F.wave * 8192);
    constexpr int NI = NCHAIN * NSEG;
    const int lo = (int)(((long)F.bid * NI) / F.nblk), hi = (int)(((long)(F.bid + 1) * NI) / F.nblk), n = hi - lo;
    for (int q = (mlo * n) + F.wave; q < mhi * n; q += 8) {
        const int mixer = q / n, r = lo + (q - mixer * n), ci = r & 31, pp = r >> 5;
        if (mixer == 0) rwkv_pass1(p, F, ci, pp, wl); else if (mixer == 1) ssd_pass1(p, F, ci, pp, wl); else gla_pass1(p, F, ci, pp, wl);
    }
}
__device__ __forceinline__ void rwkv_combine(const Params& p, const Frame& F, int ci) {
    LAS float* Sb = (LAS float*)F.lds;
    LAS float* Pb = Sb + 2 * 64 * 66;
    float* E = (float*)(p.ws + WS_RWE) + (size_t)ci * NSEG * 4096; const float* P = (const float*)(p.ws + WS_RWP) + (size_t)ci * NSEG * 4096;
    const int ti = F.wave & 3, tj0 = (F.wave >> 2) * 2, lr = F.lane & 15, lq = F.lane >> 4;
    const int prow = F.tid >> 3, pcol = (F.tid & 7) * 8;
    for (int idx = F.tid; idx < 64 * 66; idx += 512) Sb[idx] = 0.f;
    { const f32x4 a = *(const f32x4*)(P + prow * 64 + pcol), b = *(const f32x4*)(P + prow * 64 + pcol + 4);
      *(LAS f32x4*)(Pb + prow * 80 + pcol) = a; *(LAS f32x4*)(Pb + prow * 80 + pcol + 4) = b; }
    __syncthreads();
    f32x4 sreg[2] = {(f32x4){0.f, 0.f, 0.f, 0.f}, (f32x4){0.f, 0.f, 0.f, 0.f}};
    f32x4 enext[2];
#pragma unroll
    for (int t2 = 0; t2 < 2; ++t2)
#pragma unroll
        for (int e = 0; e < 4; ++e) enext[t2][e] = E[(16 * ti + 4 * lq + e) * 64 + 16 * (tj0 + t2) + lr];
    for (int pp = 0; pp < NSEG; ++pp) {
        const int cur = pp & 1; float* Ep = E + (size_t)pp * 4096;
        f32x4 acc[2] = {enext[0], enext[1]};
#pragma unroll
        for (int t2 = 0; t2 < 2; ++t2)
#pragma unroll
            for (int e = 0; e < 4; ++e) { Ep[(16 * ti + 4 * lq + e) * 64 + 16 * (tj0 + t2) + lr] = sreg[t2][e]; if (pp + 1 < NSEG) enext[t2][e] = Ep[4096 + (16 * ti + 4 * lq + e) * 64 + 16 * (tj0 + t2) + lr]; }
        if (pp == NSEG - 1) break;
        f32x4 pa, pb; const bool more = pp + 1 < NSEG - 1;
        if (more) { pa = *(const f32x4*)(P + (size_t)(pp + 1) * 4096 + prow * 64 + pcol); pb = *(const f32x4*)(P + (size_t)(pp + 1) * 4096 + prow * 64 + pcol + 4); }
        const LAS float* Sc = Sb + cur * 64 * 66; const LAS float* Pc = Pb + cur * 64 * 80;
#pragma unroll
        for (int kk = 0; kk < 16; ++kk) { const float a = Sc[(16 * ti + lr) * 66 + 4 * kk + lq], b0 = Pc[(4 * kk + lq) * 80 + 16 * tj0 + lr], b1 = Pc[(4 * kk + lq) * 80 + 16 * tj0 + 16 + lr];
            acc[0] = __builtin_amdgcn_mfma_f32_16x16x4f32(a, b0, acc[0], 0, 0, 0); acc[1] = __builtin_amdgcn_mfma_f32_16x16x4f32(a, b1, acc[1], 0, 0, 0); }
        sreg[0] = acc[0]; sreg[1] = acc[1];
        LAS float* Sn = Sb + (cur ^ 1) * 64 * 66;
#pragma unroll
        for (int t2 = 0; t2 < 2; ++t2)
#pragma unroll
            for (int e = 0; e < 4; ++e) Sn[(16 * ti + 4 * lq + e) * 66 + 16 * (tj0 + t2) + lr] = acc[t2][e];
        if (more) { LAS float* Pn = Pb + (cur ^ 1) * 64 * 80; *(LAS f32x4*)(Pn + prow * 80 + pcol) = pa; *(LAS f32x4*)(Pn + prow * 80 + pcol + 4) = pb; }
        __syncthreads();
    }
    __syncthreads();
}
__device__ __forceinline__ void ew_combine(const Params& p, int item) {
    if (item < NCHAIN * 1024) { const int ci = item >> 10, idx = (item & 1023) * 4;
        float* E = (float*)(p.ws + WS_SSE) + (size_t)ci * NSEG * 4096 + idx; const float* dec = (const float*)(p.ws + WS_SDEC) + ci * NSEG;
        f32x4 S = {0.f, 0.f, 0.f, 0.f};
#pragma unroll 4
        for (int pp = 0; pp < NSEG; ++pp) { f32x4* q = (f32x4*)(E + (size_t)pp * 4096); const f32x4 t = *q; *q = S; S = S * dec[pp] + t; }
    } else { const int it2 = item - NCHAIN * 1024, ci = it2 >> 9, idx = (it2 & 511) * 4, d = idx >> 6;
        float* E = (float*)(p.ws + WS_GLE) + (size_t)ci * NSEG * 2048 + idx; const float* dec = (const float*)(p.ws + WS_GDEC) + (size_t)ci * NSEG * 32 + d;
        f32x4 S = {0.f, 0.f, 0.f, 0.f};
#pragma unroll 4
        for (int pp = 0; pp < NSEG; ++pp) { f32x4* q = (f32x4*)(E + (size_t)pp * 2048); const f32x4 t = *q; *q = S; S = S * dec[pp * 32] + t; }
    }
}
__device__ __forceinline__ void att_item(const Params& p, const Frame& F, int item, float mshift) {
    const bool isctx = item >= 512; int b, hkv, qb;
    if (!isctx) { b = item >> 7; hkv = (item >> 6) & 1; qb = item & 63; } else { const int i2 = item - 512; b = i2 >> 3; hkv = (i2 >> 2) & 1; qb = i2 & 3; }
    const int kt0 = isctx ? 64 : 0, kt1 = 68;
    const bf16_t* Kg = (const bf16_t*)(p.ws + WS_ATTK) + (size_t)(b * 2 + hkv) * NKEY * 64;
    const bf16_t* Vg = (const bf16_t*)(p.ws + WS_ATTVT) + (size_t)(b * 2 + hkv) * 64 * NKEY;
    const bf16_t* Qg = (const bf16_t*)(p.ws + WS_ATTQ); bf16_t* atto = (bf16_t*)(p.ws + WS_ATTO);
    const int hq = hkv * 2 + (F.wave >> 2), q0 = qb * 64 + (F.wave & 3) * 16, c = F.lane & 15, g = F.lane >> 4;
    const int qtok = isctx ? (TL + b * CTXL + q0 + c) : (b * SEQ + q0 + c);
    bf16x8 qf[2];
#pragma unroll
    for (int dc = 0; dc < 2; ++dc) qf[dc] = *(const bf16x8*)(Qg + (size_t)qtok * 256 + hq * 64 + 32 * dc + 8 * g);
    const int srow = F.tid >> 3, sch = F.tid & 7;
    u32x4 kreg = *(const u32x4*)(Kg + (size_t)(kt0 * 64 + srow) * 64 + sch * 8), vreg = *(const u32x4*)(Vg + (size_t)srow * NKEY + kt0 * 64 + sch * 8);
    *(LAS u32x4*)(F.lds + srow * 144 + sch * 16) = kreg; *(LAS u32x4*)(F.lds + 9216 + srow * 144 + sch * 16) = vreg;
    __syncthreads();
    f32x4 O[4]; float lsum = 0.f;
#pragma unroll
    for (int dt = 0; dt < 4; ++dt) O[dt] = (f32x4){0.f, 0.f, 0.f, 0.f};
    for (int kt = kt0; kt < kt1; ++kt) {
        const int cur = (kt - kt0) & 1; const bool more = kt + 1 < kt1;
        if (more) { kreg = *(const u32x4*)(Kg + (size_t)((kt + 1) * 64 + srow) * 64 + sch * 8); vreg = *(const u32x4*)(Vg + (size_t)srow * NKEY + (kt + 1) * 64 + sch * 8); }
        const LAS unsigned char* Ks = F.lds + cur * 18432; const LAS unsigned char* Vs = Ks + 9216;
        f32x4 st[4];
#pragma unroll
        for (int ks = 0; ks < 4; ++ks) { st[ks] = (f32x4){-mshift, -mshift, -mshift, -mshift};
#pragma unroll
            for (int dc = 0; dc < 2; ++dc) { const bf16x8 kf = *(const LAS bf16x8*)(Ks + (16 * ks + c) * 144 + (32 * dc + 8 * g) * 2); st[ks] = __builtin_amdgcn_mfma_f32_16x16x32_bf16(kf, qf[dc], st[ks], 0, 0, 0); } }
        float ps = 0.f;
#pragma unroll
        for (int ks = 0; ks < 4; ++ks)
#pragma unroll
            for (int i = 0; i < 4; ++i) { st[ks][i] = __builtin_amdgcn_exp2f(st[ks][i]); ps += st[ks][i]; }
        lsum += ps;
#pragma unroll
        for (int kc = 0; kc < 2; ++kc) {
            u32x4 pw; pw.x = cvt_pk_bf16(st[2 * kc][0], st[2 * kc][1]); pw.y = cvt_pk_bf16(st[2 * kc][2], st[2 * kc][3]); pw.z = cvt_pk_bf16(st[2 * kc + 1][0], st[2 * kc + 1][1]); pw.w = cvt_pk_bf16(st[2 * kc + 1][2], st[2 * kc + 1][3]);
            const bf16x8 pf = __builtin_bit_cast(bf16x8, pw);
#pragma unroll
            for (int dt = 0; dt < 4; ++dt) {
                const u32x2 v0 = *(const LAS u32x2*)(Vs + (16 * dt + c) * 144 + (32 * kc + 4 * g) * 2), v1 = *(const LAS u32x2*)(Vs + (16 * dt + c) * 144 + (32 * kc + 16 + 4 * g) * 2);
                u32x4 vw; vw.x = v0.x; vw.y = v0.y; vw.z = v1.x; vw.w = v1.y;
                O[dt] = __builtin_amdgcn_mfma_f32_16x16x32_bf16(__builtin_bit_cast(bf16x8, vw), pf, O[dt], 0, 0, 0);
            }
        }
        if (more) { *(LAS u32x4*)(F.lds + (cur ^ 1) * 18432 + srow * 144 + sch * 16) = kreg; *(LAS u32x4*)(F.lds + (cur ^ 1) * 18432 + 9216 + srow * 144 + sch * 16) = vreg; }
        __syncthreads();
    }
    lsum += __shfl_xor(lsum, 16); lsum += __shfl_xor(lsum, 32);
    const float il = 1.0f / lsum;
#pragma unroll
    for (int dt = 0; dt < 4; ++dt) { u32x2 w; w.x = cvt_pk_bf16(O[dt][0] * il, O[dt][1] * il); w.y = cvt_pk_bf16(O[dt][2] * il, O[dt][3] * il);
        *(u32x2*)(atto + (size_t)qtok * 256 + hq * 64 + 16 * dt + 4 * g) = w; }
}
__device__ __forceinline__ void pass3_item(const Params& p, const Frame& F, int it) {
    const int mixer = it / 1088, r = it % 1088, bh = r & 15, tb = r >> 4, b = bh >> 2, h = bh & 3;
    const int r0 = tb < 4 ? TL + b * CTXL + tb * 64 : b * SEQ + (tb - 4) * 64;
    const int ppf = tb, ppb = tb < 4 ? 3 - tb : 71 - tb, cif = bh * 2, cib = cif + 1;
    LAS float* Zf = (LAS float*)F.lds;
    LAS float* Sf = Zf + 64 * 66;
    LAS float* Zb = Sf + 64 * 66; LAS float* Sb = Zb + 64 * 66;
    const int t = F.tid >> 3;
    if (mixer < 2) {
        const float* Z0 = (const float*)(p.ws + (mixer == 0 ? WS_ZRW : WS_ZSS)); const float* Z1 = Z0 + (size_t)T * 256;
        const float* E0 = (const float*)(p.ws + (mixer == 0 ? WS_RWE : WS_SSE));
        const float* SSf = E0 + (size_t)(cif * NSEG + ppf) * 4096; const float* SSb = E0 + (size_t)(cib * NSEG + ppb) * 4096;
        const int c0 = (F.tid & 7) * 8; const size_t zo = (size_t)(r0 + t) * 256 + h * 64 + c0;
        const f32x4 a0 = *(const f32x4*)(Z0 + zo), a1 = *(const f32x4*)(Z0 + zo + 4), b0 = *(const f32x4*)(Z1 + zo), b1 = *(const f32x4*)(Z1 + zo + 4);
        const f32x4 s0 = *(const f32x4*)(SSf + t * 64 + c0), s1 = *(const f32x4*)(SSf + t * 64 + c0 + 4), u0 = *(const f32x4*)(SSb + t * 64 + c0), u1 = *(const f32x4*)(SSb + t * 64 + c0 + 4);
        LAS f32x2v* q;
        q = (LAS f32x2v*)(Zf + t * 66 + c0); q[0] = (f32x2v){a0.x, a0.y}; q[1] = (f32x2v){a0.z, a0.w}; q[2] = (f32x2v){a1.x, a1.y}; q[3] = (f32x2v){a1.z, a1.w};
        q = (LAS f32x2v*)(Zb + t * 66 + c0); q[0] = (f32x2v){b0.x, b0.y}; q[1] = (f32x2v){b0.z, b0.w}; q[2] = (f32x2v){b1.x, b1.y}; q[3] = (f32x2v){b1.z, b1.w};
        q = (LAS f32x2v*)(Sf + t * 66 + c0); q[0] = (f32x2v){s0.x, s0.y}; q[1] = (f32x2v){s0.z, s0.w}; q[2] = (f32x2v){s1.x, s1.y}; q[3] = (f32x2v){s1.z, s1.w};
        q = (LAS f32x2v*)(Sb + t * 66 + c0); q[0] = (f32x2v){u0.x, u0.y}; q[1] = (f32x2v){u0.z, u0.w}; q[2] = (f32x2v){u1.x, u1.y}; q[3] = (f32x2v){u1.z, u1.w};
    } else {
        const float* Z0 = (const float*)(p.ws + WS_ZGL); const float* Z1 = Z0 + (size_t)T * 128;
        const float* E0 = (const float*)(p.ws + WS_GLE);
        const float* SSf = E0 + (size_t)(cif * NSEG + ppf) * 2048; const float* SSb = E0 + (size_t)(cib * NSEG + ppb) * 2048;
        const int c0 = (F.tid & 7) * 4; const size_t zo = (size_t)(r0 + t) * 128 + h * 32 + c0;
        const f32x4 a0 = *(const f32x4*)(Z0 + zo), b0 = *(const f32x4*)(Z1 + zo);
        const int idx = F.tid * 4, d = idx >> 6, v0 = idx & 63;
        const f32x4 s0 = *(const f32x4*)(SSf + idx), u0 = *(const f32x4*)(SSb + idx);
        LAS f32x2v* q;
        q = (LAS f32x2v*)(Zf + t * 66 + c0); q[0] = (f32x2v){a0.x, a0.y}; q[1] = (f32x2v){a0.z, a0.w};
        q = (LAS f32x2v*)(Zb + t * 66 + c0); q[0] = (f32x2v){b0.x, b0.y}; q[1] = (f32x2v){b0.z, b0.w};
        *(LAS f32x4*)(Sf + d * 80 + v0) = s0; *(LAS f32x4*)(Sb + d * 80 + v0) = u0;
    }
    const int ti = F.wave & 3, tj0 = (F.wave >> 2) * 2, lr = F.lane & 15, lq = F.lane >> 4;
    float* Y0 = (float*)(p.ws + WS_Y) + (size_t)(mixer == 0 ? 2 : (mixer == 1 ? 1 : 0)) * T * 256; const float* Y1 = (const float*)(p.ws + WS_Y2) + (size_t)(mixer == 0 ? 2 : (mixer == 1 ? 1 : 0)) * T * 256;
    f32x4 acc[2];
#pragma unroll
    for (int t2 = 0; t2 < 2; ++t2)
#pragma unroll
        for (int e = 0; e < 4; ++e) { const size_t o = (size_t)(r0 + 16 * ti + 4 * lq + e) * 256 + h * 64 + 16 * (tj0 + t2) + lr; acc[t2][e] = Y0[o] + Y1[o]; }
    __syncthreads();
    if (mixer < 2) {
#pragma unroll
        for (int kk = 0; kk < 16; ++kk) { const float a = Zf[(16 * ti + lr) * 66 + 4 * kk + lq], b0 = Sf[(16 * tj0 + lr) * 66 + 4 * kk + lq], b1 = Sf[(16 * tj0 + 16 + lr) * 66 + 4 * kk + lq];
            acc[0] = __builtin_amdgcn_mfma_f32_16x16x4f32(a, b0, acc[0], 0, 0, 0); acc[1] = __builtin_amdgcn_mfma_f32_16x16x4f32(a, b1, acc[1], 0, 0, 0); }
#pragma unroll
        for (int kk = 0; kk < 16; ++kk) { const float a = Zb[(16 * ti + lr) * 66 + 4 * kk + lq], b0 = Sb[(16 * tj0 + lr) * 66 + 4 * kk + lq], b1 = Sb[(16 * tj0 + 16 + lr) * 66 + 4 * kk + lq];
            acc[0] = __builtin_amdgcn_mfma_f32_16x16x4f32(a, b0, acc[0], 0, 0, 0); acc[1] = __builtin_amdgcn_mfma_f32_16x16x4f32(a, b1, acc[1], 0, 0, 0); }
    } else {
#pragma unroll
        for (int kk = 0; kk < 8; ++kk) { const float a = Zf[(16 * ti + lr) * 66 + 4 * kk + lq], b0 = Sf[(4 * kk + lq) * 80 + 16 * tj0 + lr], b1 = Sf[(4 * kk + lq) * 80 + 16 * tj0 + 16 + lr];
            acc[0] = __builtin_amdgcn_mfma_f32_16x16x4f32(a, b0, acc[0], 0, 0, 0); acc[1] = __builtin_amdgcn_mfma_f32_16x16x4f32(a, b1, acc[1], 0, 0, 0); }
#pragma unroll
        for (int kk = 0; kk < 8; ++kk) { const float a = Zb[(16 * ti + lr) * 66 + 4 * kk + lq], b0 = Sb[(4 * kk + lq) * 80 + 16 * tj0 + lr], b1 = Sb[(4 * kk + lq) * 80 + 16 * tj0 + 16 + lr];
            acc[0] = __builtin_amdgcn_mfma_f32_16x16x4f32(a, b0, acc[0], 0, 0, 0); acc[1] = __builtin_amdgcn_mfma_f32_16x16x4f32(a, b1, acc[1], 0, 0, 0); }
    }
#pragma unroll
    for (int t2 = 0; t2 < 2; ++t2)
#pragma unroll
        for (int e = 0; e < 4; ++e) Y0[(size_t)(r0 + 16 * ti + 4 * lq + e) * 256 + h * 64 + 16 * (tj0 + t2) + lr] = acc[t2][e];
    __syncthreads();
}
__device__ __forceinline__ void phase_s2(const Params& p, const Frame& F, int l) {
    float mshift;
    { const float gq = fabsf(p.in[I_ATT_QN][l * 64 + F.lane]), gk = fabsf(p.in[I_ATT_KN][l * 64 + F.lane]); float mq = gq, mk = gk;
#pragma unroll
      for (int o = 1; o < 64; o <<= 1) { mq = fmaxf(mq, __shfl_xor(mq, o)); mk = fmaxf(mk, __shfl_xor(mk, o)); }
      mshift = 8.0f * mq * mk * 1.4426950408889634f; }
    for (int ci = F.bid; ci < NCHAIN; ci += F.nblk) rwkv_combine(p, F, ci);
    { const int vb = (F.bid + F.nblk - 32) % F.nblk;
      for (int it = vb * 512 + F.tid; it < NCHAIN * 1536; it += F.nblk * 512) ew_combine(p, it); }
#ifndef ATT_REP
#define ATT_REP 1
#endif
    for (int rep = 0; rep < ATT_REP; ++rep)
    if (F.nblk == 256) {
        if (F.bid >= 128) { for (int k = 0; k < 3; ++k) att_item(p, F, F.bid - 128 + 128 * k, mshift); if (F.bid < 160) att_item(p, F, 512 + F.bid - 128, mshift); }
        else att_item(p, F, 384 + F.bid, mshift);
    } else { for (int item = F.bid; item < 544; item += F.nblk) att_item(p, F, item, mshift); }
    if (F.nblk == 256 && F.bid >= 32 && F.bid < 128) { const int gwc = (F.bid - 32) * 8 + F.wave, ngw = 96 * 8;
        phase_conv(p, F, l, 2 | 8 | 32, gwc, ngw); if (l < DEPTH - 1) phase_conv(p, F, l + 1, 1 | 4 | 16, gwc, ngw); }
    else if (F.nblk != 256) { phase_conv(p, F, l, 2 | 8 | 32, F.bid * 8 + F.wave, F.nblk * 8); if (l < DEPTH - 1) phase_conv(p, F, l + 1, 1 | 4 | 16, F.bid * 8 + F.wave, F.nblk * 8); }
}
__device__ __forceinline__ void phase_s3(const Params& p, const Frame& F) {
    for (int it = F.bid; it < 3 * 1088; it += F.nblk) pass3_item(p, F, it);
}
__device__ __forceinline__ void phase_finish(const Params& p, const Frame& F, int l) {
    const bf16_t* U = (const bf16_t*)(p.ws + WS_U); const float* Yg = (const float*)(p.ws + WS_Y); const float* Ys = Yg + (size_t)T * 256; const float* Yr = Ys + (size_t)T * 256;
    const float* XBC = (const float*)(p.ws + WS_XBC); const float* S = (const float*)(p.ws + WS_RW); const float* G = (const float*)(p.ws + WS_G);
    const bf16_t* atto = (const bf16_t*)(p.ws + WS_ATTO);
    bf16_t* cat = (bf16_t*)(p.ws + WS_CAT);
    const int c4 = F.lane * 4, head = F.lane >> 4, hc = c4 & 63;
    const f32x4 glan = *(const f32x4*)(p.in[I_GLA_NORM] + l * 64 + hc), ssmn = *(const f32x4*)(p.in[I_SSM_NORM] + l * 256 + c4);
    const float dsk = p.in[I_SSM_D][l * 4 + head];
    const f32x4 lng = *(const f32x4*)(p.in[I_RW_LNG] + l * 256 + c4), lnb = *(const f32x4*)(p.in[I_RW_LNB] + l * 256 + c4), rk = *(const f32x4*)(p.in[I_RW_RK] + l * 256 + c4);
    const int nw = F.nblk * 8, gw = F.bid * 8 + F.wave;
    const int lo = (int)(((long)gw * T) / nw), hi = (int)(((long)(gw + 1) * T) / nw);
    for (int r0 = lo; r0 < hi; r0 += 2) {
        f32x4 og[2], gt[2], ys[2], xs[2], z[2], yr[2], rr[2], kk[2], vv[2], gg[2]; u32x2 ao[2];
#pragma unroll
        for (int k = 0; k < 2; ++k) { const int r = r0 + k < hi ? r0 + k : hi - 1; const bf16_t* ur = U + (size_t)r * NINP; const float* sb = S + ((size_t)r * 4 + head) * 448 + hc;
            og[k] = *(const f32x4*)(Yg + (size_t)r * 256 + c4); gt[k] = ldbf4(ur + U_GLA_G + c4);
            ys[k] = *(const f32x4*)(Ys + (size_t)r * 256 + c4); xs[k] = *(const f32x4*)(XBC + (size_t)r * 512 + c4); z[k] = ldbf4(ur + U_SSM_Z + c4);
            yr[k] = *(const f32x4*)(Yr + (size_t)r * 256 + c4); rr[k] = *(const f32x4*)(sb); kk[k] = *(const f32x4*)(sb + 192); vv[k] = *(const f32x4*)(sb + 384); gg[k] = *(const f32x4*)(G + (size_t)r * 256 + c4);
            ao[k] = *(const u32x2*)(atto + (size_t)r * 256 + c4); }
#pragma unroll
        for (int k = 0; k < 2; ++k) { const int r = r0 + k; if (r < hi) {
            bf16_t* cr = cat + (size_t)r * D;
            u32x2 w0, w1, w2;
            { const float ss = sum16((og[k].x * og[k].x + og[k].y * og[k].y) + (og[k].z * og[k].z + og[k].w * og[k].w)); const float rs = 1.0f / sqrtf(ss * (1.0f / 64.0f) + 1e-6f);
              f32x4 y;
#pragma unroll
              for (int e = 0; e < 4; ++e) y[e] = og[k][e] * rs * glan[e] * silu_fast2(gt[k][e]);
              w0.x = cvt_pk_bf16(y[0], y[1]); w0.y = cvt_pk_bf16(y[2], y[3]); }
            { f32x4 y; float ss = 0.f;
#pragma unroll
              for (int e = 0; e < 4; ++e) { y[e] = (ys[k][e] + dsk * xs[k][e]) * silu_fast2(z[k][e]); ss += y[e] * y[e]; }
              ss = wave_sum(ss); const float rs = 1.0f / sqrtf(ss * (1.0f / 256.0f) + 1e-6f);
              w1.x = cvt_pk_bf16(y[0] * rs * ssmn[0], y[1] * rs * ssmn[1]); w1.y = cvt_pk_bf16(y[2] * rs * ssmn[2], y[3] * rs * ssmn[3]); }
            { const float mu = sum16((yr[k].x + yr[k].y) + (yr[k].z + yr[k].w)) * (1.0f / 64.0f);
              const f32x4 dlt = yr[k] - mu; const float var = sum16((dlt.x * dlt.x + dlt.y * dlt.y) + (dlt.z * dlt.z + dlt.w * dlt.w)) * (1.0f / 64.0f);
              const float rs = 1.0f / sqrtf(var + 64e-5f);
              const float dot = sum16((rr[k].x * kk[k].x * rk.x + rr[k].y * kk[k].y * rk.y) + (rr[k].z * kk[k].z * rk.z + rr[k].w * kk[k].w * rk.w));
              f32x4 o;
#pragma unroll
              for (int e = 0; e < 4; ++e) o[e] = (dlt[e] * rs * lng[e] + lnb[e] + dot * vv[k][e]) * gg[k][e];
              w2.x = cvt_pk_bf16(o[0], o[1]); w2.y = cvt_pk_bf16(o[2], o[3]); }
            *(u32x2*)(cr + c4) = w0; *(u32x2*)(cr + 256 + c4) = w1; *(u32x2*)(cr + 512 + c4) = w2; *(u32x2*)(cr + 768 + c4) = ao[k]; } }
    }
}
#ifndef EXP
#define EXP 0
#endif
#if EXP == 0
constexpr int NPH_LAYER = 15;
__device__ __forceinline__ int phase_type(int s) { switch (s) { case 0: return 0; case 1: return 1; case 2: return 2; case 3: return 3; case 4: return 4; case 5: return 5; case 6: return 6; case 7: return 7; case 8: return 8; case 9: return 9; case 10: return 10; case 11: return 11; case 12: return 12; case 13: return 13; case 14: return 14; default: return 0; } }
#endif
#if EXP == 1
constexpr int NPH_LAYER = 18;
__device__ __forceinline__ int phase_type(int s) { switch (s) { case 0: return 0; case 1: return 1; case 2: return 2; case 3: return 2; case 4: return 3; case 5: return 4; case 6: return 5; case 7: return 5; case 8: return 6; case 9: return 7; case 10: return 8; case 11: return 9; case 12: return 10; case 13: return 11; case 14: return 12; case 15: return 13; case 16: return 13; case 17: return 14; default: return 0; } }
#endif
#if EXP == 2
constexpr int NPH_LAYER = 20;
__device__ __forceinline__ int phase_type(int s) { switch (s) { case 0: return 0; case 1: return 0; case 2: return 1; case 3: return 1; case 4: return 2; case 5: return 3; case 6: return 4; case 7: return 4; case 8: return 5; case 9: return 6; case 10: return 7; case 11: return 8; case 12: return 9; case 13: return 10; case 14: return 10; case 15: return 11; case 16: return 12; case 17: return 12; case 18: return 13; case 19: return 14; default: return 0; } }
#endif
#if EXP == 3
constexpr int NPH_LAYER = 17;
__device__ __forceinline__ int phase_type(int s) { switch (s) { case 0: return 0; case 1: return 1; case 2: return 2; case 3: return 3; case 4: return 4; case 5: return 5; case 6: return 6; case 7: return 7; case 8: return 6; case 9: return 7; case 10: return 8; case 11: return 9; case 12: return 10; case 13: return 11; case 14: return 12; case 15: return 13; case 16: return 14; default: return 0; } }
#endif
#if EXP == 4
constexpr int NPH_LAYER = 16;
__device__ __forceinline__ int phase_type(int s) { switch (s) { case 0: return 0; case 1: return 1; case 2: return 2; case 3: return 3; case 4: return 4; case 5: return 5; case 6: return 6; case 7: return 6; case 8: return 7; case 9: return 8; case 10: return 9; case 11: return 10; case 12: return 11; case 13: return 12; case 14: return 13; case 15: return 14; default: return 0; } }
#endif
#if EXP == 5
constexpr int NPH_LAYER = 17;
__device__ __forceinline__ int phase_type(int s) { switch (s) { case 0: return 0; case 1: return 1; case 2: return 2; case 3: return 3; case 4: return 4; case 5: return 5; case 6: return 6; case 7: return 7; case 8: return 8; case 9: return 9; case 10: return 10; case 11: return 10; case 12: return 10; case 13: return 11; case 14: return 12; case 15: return 13; case 16: return 14; default: return 0; } }
#endif
#if EXP == 6
constexpr int NPH_LAYER = 20;
__device__ __forceinline__ int phase_type(int s) { switch (s) { case 0: return 0; case 1: return 1; case 2: return 2; case 3: return 3; case 4: return 4; case 5: return 5; case 6: return 6; case 7: return 7; case 8: return 8; case 9: return 9; case 10: return 10; case 11: return 11; case 12: return 12; case 13: return 13; case 14: return 14; case 15: return 99; case 16: return 99; case 17: return 99; case 18: return 99; case 19: return 99; default: return 0; } }
#endif
#if EXP == 7
constexpr int NPH_LAYER = 16;
__device__ __forceinline__ int phase_type(int s) { switch (s) { case 0: return 0; case 1: return 1; case 2: return 2; case 3: return 3; case 4: return 4; case 5: return 5; case 6: return 6; case 7: return 7; case 8: return 7; case 9: return 8; case 10: return 9; case 11: return 10; case 12: return 11; case 13: return 12; case 14: return 13; case 15: return 14; default: return 0; } }
#endif
#if EXP == 8
constexpr int NPH_LAYER = 16;
__device__ __forceinline__ int phase_type(int s) { switch (s) { case 0: return 0; case 1: return 1; case 2: return 2; case 3: return 3; case 4: return 4; case 5: return 5; case 6: return 6; case 7: return 7; case 8: return 70; case 9: return 8; case 10: return 9; case 11: return 10; case 12: return 11; case 13: return 12; case 14: return 13; case 15: return 14; default: return 0; } }
#endif
#if EXP == 9
constexpr int NPH_LAYER = 16;
__device__ __forceinline__ int phase_type(int s) { switch (s) { case 0: return 0; case 1: return 1; case 2: return 2; case 3: return 3; case 4: return 4; case 5: return 5; case 6: return 6; case 7: return 7; case 8: return 71; case 9: return 8; case 10: return 9; case 11: return 10; case 12: return 11; case 13: return 12; case 14: return 13; case 15: return 14; default: return 0; } }
#endif
#if EXP == 10
constexpr int NPH_LAYER = 16;
__device__ __forceinline__ int phase_type(int s) { switch (s) { case 0: return 0; case 1: return 1; case 2: return 2; case 3: return 3; case 4: return 30; case 5: return 4; case 6: return 5; case 7: return 6; case 8: return 7; case 9: return 8; case 10: return 9; case 11: return 10; case 12: return 11; case 13: return 12; case 14: return 13; case 15: return 14; default: return 0; } }
#endif
#if EXP == 11
constexpr int NPH_LAYER = 16;
__device__ __forceinline__ int phase_type(int s) { switch (s) { case 0: return 0; case 1: return 1; case 2: return 2; case 3: return 3; case 4: return 4; case 5: return 5; case 6: return 6; case 7: return 7; case 8: return 8; case 9: return 9; case 10: return 10; case 11: return 11; case 12: return 31; case 13: return 12; case 14: return 13; case 15: return 14; default: return 0; } }
#endif
constexpr int NPHASES = NPH_LAYER * DEPTH;
__global__ void __launch_bounds__(512) mega(Params p0) {
    extern __shared__ __attribute__((aligned(16))) unsigned char lds_raw[];
    cg::grid_group grid = cg::this_grid();
    { volatile LAS unsigned* st0 = (volatile LAS unsigned*)((LAS unsigned char*)lds_raw + 131072); if (threadIdx.x < 2) st0[threadIdx.x] = 0u; }
    __syncthreads();
    const XcdBarrier xbar = xcd_barrier_post((unsigned*)(p0.ws + WS_BAR), (volatile LAS unsigned*)((LAS unsigned char*)lds_raw + 131072));
    for (int ph = p0.ph_lo; ph < p0.ph_hi; ++ph) {
        int tid_ = threadIdx.x; asm volatile("" : "+v"(tid_));
        size_t zoff_ = 0; asm volatile("" : "+s"(zoff_));
        Params p = p0; p.ws = p0.ws + zoff_; p.out = p0.out + zoff_;
        int bid_ = blockIdx.x, nblk_ = gridDim.x; asm volatile("" : "+s"(bid_), "+s"(nblk_));
        Frame F; F.bid = bid_; F.nblk = nblk_; F.lds = (LAS unsigned char*)lds_raw; F.tid = tid_; F.lane = F.tid & 63; F.wave = __builtin_amdgcn_readfirstlane(F.tid >> 6);
        const int l = ph / NPH_LAYER, s = phase_type(ph % NPH_LAYER);
        if (s == 0 && l > 0) continue;
        if (s == 0) {
#ifndef SKIP_A
 if (l == 0) { phase_mod_init(p, F); phase_conv(p, F, 0, 1 | 4 | 16, F.bid * 8 + F.wave, F.nblk * 8); }
#endif
 }
        else if (s == 1 || s == 4 || s == 12) {
#ifndef SKIP_B
 { const int which = s == 1 ? 0 : (s == 4 ? 1 : 2);
   const bool pend = which == 0 ? l > 0 : (which == 1 ? true : l < DEPTH - 1);
   const int pl = which == 0 ? l - 1 : l, pgate = which == 0 ? 8 : (which == 1 ? 2 : 5);
   phase_normmod(p, F, l, which, (l == DEPTH - 1 && s == 12) ? TL : T, pend ? (which == 2 ? 4 : 11) : 0, (const float*)(p.ws + WS_MOD) + (size_t)(pl * 5 + 4) * NMODC + pgate * D, which == 2 ? 1.0f : 0.5f); }
#endif
 }
        else if (s == 2 || s == 13) { const int f = s == 13;
            pg8::Gemm g; g.A = (const bf16_t*)(p.ws + WS_HA); const int Mr = (l == DEPTH - 1 && f) ? TL : T;
            g.Bt = (const bf16_t*)(p.ws + WS_WUP) + (size_t)f * NUP * D; g.M = Mr; g.N = NUP; g.K = D; g.ldk = D;
            pg8::StaticOrder so; so.init(Mr, NUP, F.nblk, F.bid);
            pg8::EpiSwiglu e; e.O = (bf16_t*)(p.ws + WS_HID); e.ldc = DFF;

#ifndef SKIP_C
 pg8::gemm_phase<pg8::EpiSwiglu, pg8::StaticOrder, false>(F.lds, g, so, e, nullptr);
#endif
 }
        else if (s == 3 || s == 14 || s == 11 || s == 30 || s == 31) { const int f = s == 14; const bool isout = s == 11 || s == 31; const bool probe = s >= 30;
            pg8::Gemm g; g.A = isout ? (const bf16_t*)(p.ws + WS_CAT) : (const bf16_t*)(p.ws + WS_HID);
            g.Bt = isout ? (const bf16_t*)(p.ws + WS_WOUT) : (const bf16_t*)(p.ws + WS_WDN) + (size_t)f * D * DFF; const int Mr = (l == DEPTH - 1 && (isout || f)) ? TL : T;
            g.M = TL; g.N = D; g.K = isout ? D : DFF; g.ldk = g.K;
            pg8::StaticOrder so; so.init(TL, D, F.nblk, F.bid);
            pg8::EpiResid e; e.xlat = p.out; e.xctx = (float*)(p.ws + WS_XCTX); e.gate = (const float*)(p.ws + WS_MOD) + (size_t)(l * 5) * NMODC + (isout ? 5 : (f ? 8 : 2)) * D; e.coef = probe ? 0.0f : (isout ? 1.0f : 0.5f);

#ifndef SKIP_D
 pg8::gemm_phase<pg8::EpiResid, pg8::StaticOrder, false>(F.lds, g, so, e, nullptr);
#endif
            if (Mr == T && !probe) {
                pg8::Gemm g2 = g; g2.K = 256; g2.ldk = g.K;
                pg8::SliceOrder so2; so2.nslice = g.K / 256; so2.c = F.bid;
                pg8::EpiStorePart e2; e2.part = (float*)(p.ws + WS_U); e2.nslice = so2.nslice;
                pg8::gemm_phase<pg8::EpiStorePart, pg8::SliceOrder, false>(F.lds, g2, so2, e2, nullptr);
            }
 }
        else if (s == 5) {
            pg8::Gemm g; g.A = (const bf16_t*)(p.ws + WS_HA); g.Bt = (const bf16_t*)(p.ws + WS_WIN); g.M = T; g.N = NINP; g.K = D; g.ldk = D;
            pg8::StaticOrder so; so.init(T, NINP, F.nblk, F.bid);
            pg8::EpiStoreBf16 e; e.O = (bf16_t*)(p.ws + WS_U); e.ldc = NINP;

#ifndef SKIP_E
 pg8::gemm_phase<pg8::EpiStoreBf16, pg8::StaticOrder, false>(F.lds, g, so, e, nullptr);
#endif
 }
        else if (s == 6) {
#ifndef SKIP_F
 phase_prep(p, F, l);
#endif
 }
        else if (s == 7) {
#ifndef SKIP_G
 phase_s1(p, F);
#endif
 }
        else if (s == 70) phase_s1(p, F, 0, 1);
        else if (s == 71) phase_s1(p, F, 1, 3);
        else if (s == 8) {
#ifndef SKIP_I
 phase_s2(p, F, l);
#endif
 }
        else if (s == 9) {
#ifndef SKIP_J
 phase_s3(p, F);
#endif
 }
        else if (s == 10) {
#ifndef SKIP_H
 phase_finish(p, F, l);
#endif
 }
        if (ph + 1 < p0.ph_hi) { if (ph == p0.ph_lo) grid.sync(); else xcd_barrier(xbar); }
    }
}

extern "C" void kernel_launch(void* const* d_in, const int* in_sizes, int n_in, void* d_out, int out_size, void* d_ws, size_t ws_size, hipStream_t stream) {
    static int grid_blocks = 0;
    if (!grid_blocks) {
        int dev = 0, cus = 0, per_cu = 0;
        (void)hipGetDevice(&dev);
        (void)hipDeviceGetAttribute(&cus, hipDeviceAttributeMultiprocessorCount, dev);
        (void)hipFuncSetAttribute((const void*)mega, hipFuncAttributeMaxDynamicSharedMemorySize, LDS_BYTES);
        (void)hipOccupancyMaxActiveBlocksPerMultiprocessor(&per_cu, (const void*)mega, 512, LDS_BYTES);
        if (per_cu < 1) per_cu = 1;
        grid_blocks = cus * per_cu;
        if (n_in != N_INPUTS || out_size != TL * D || ws_size < WS_END) { fprintf(stderr, "kernel_launch: unexpected sizes n_in %d out %d ws %zu (need %zu)\n", n_in, out_size, ws_size, (size_t)WS_END); grid_blocks = -1; }
    }
    if (grid_blocks < 0) return;
    Params p{};
    for (int i = 0; i < N_INPUTS; ++i) p.in[i] = (const float*)d_in[i];
    p.out = (float*)d_out; p.ws = (unsigned char*)d_ws; p.ph_lo = 0; p.ph_hi = NPHASES;
    (void)hipMemsetAsync((unsigned char*)d_ws + WS_BAR, 0, 16384, stream);
    void* args[] = {&p};
    hipError_t e = hipLaunchCooperativeKernel((void*)mega, dim3(grid_blocks), dim3(512), args, LDS_BYTES, stream);
    if (e != hipSuccess) fprintf(stderr, "cooperative launch failed: %s (grid %d)\n", hipGetErrorString(e), grid_blocks);
}
```

```cpp
#include <hip/hip_runtime.h>
#include <hip/hip_cooperative_groups.h>
#include <cstdio>
#include <cstdint>
namespace cg = cooperative_groups;
constexpr int D = 1024, NBATCH = 4, SEQ = 4096, DEPTH = 4, CTXL = 256;
constexpr int TL = NBATCH * SEQ, TC = NBATCH * CTXL, T = TL + TC;
constexpr int DFF = 2816, NUP = 2 * DFF, NIN = 3092, NINP = 3328, NMODC = 9 * D;
namespace pg8 {
#define PG8_LAS __attribute__((address_space(3)))
typedef unsigned short bf16_t;
typedef short bf16x8 __attribute__((ext_vector_type(8)));
typedef float f32x4 __attribute__((ext_vector_type(4)));
typedef unsigned u32x4 __attribute__((ext_vector_type(4)));
constexpr int BM = 256, BK = 64, HALF = 128, HTB = HALF * BK * 2  , STAGE_BYTES = 8 * HTB, NXCD = 8, WGM = 8;

__host__ __device__ __forceinline__ int lds_byte(int r, int c) { const int st = (r >> 4) * 2 + (c >> 5), rr = r & 15, cc = c & 31, ob = rr * 64 + cc * 2; return st * 1024 + (ob ^ (((ob >> 9) & 1) << 5)); }
__host__ __device__ __forceinline__ void stage_rc(int b, int& R, int& C) { const int st = b / 1024, sb = b % 1024, swz = sb ^ (((sb >> 9) & 1) << 5); R = (st >> 1) * 16 + swz / 64; C = (st & 1) * 32 + (swz % 64) / 2; }
__host__ __device__ __forceinline__ int perm32(int rho) { const int n = rho >> 4, i = rho & 15; return 8 * (i >> 2) + 4 * n + (i & 3); }

struct Unit { int pm, pn, ks; };
struct Gemm { const bf16_t* A; const bf16_t* Bt; int M, N, K, ldk; };

struct StaticOrder {
    int nM, nN, nwg, G, c;
    __host__ __device__ void init(int M, int N, int G_, int c_) { nM = M / BM; nN = N / BM; nwg = nM * nN; G = G_; c = c_; }
    __host__ __device__ bool next(int i, Unit& u) const {
        const long L = (long)i * G + c; if (L >= nwg) return false;
        int wgid = (int)L; { const int q = nwg / NXCD, r = nwg % NXCD, xcd = wgid % NXCD, off = wgid / NXCD; wgid = (xcd < r ? xcd * (q + 1) : r * (q + 1) + (xcd - r) * q) + off; }
        const int nig = WGM * nN, gid = wgid / nig, fm = gid * WGM, gsz = (nM - fm) < WGM ? (nM - fm) : WGM;
        u.pm = fm + ((wgid % nig) % gsz); u.pn = (wgid % nig) / gsz; u.ks = 0; return true;
    }
    __device__ __forceinline__ void a_ready(const Unit&) const {}
    __device__ __forceinline__ void done(const Unit&) const {}
};
__device__ __forceinline__ unsigned cvt_pk_bf16(float lo, float hi) { unsigned r; asm volatile("s_nop 0\n\tv_cvt_pk_bf16_f32 %0, %1, %2" : "=v"(r) : "v"(lo), "v"(hi)); return r; }
typedef float f32x2 __attribute__((ext_vector_type(2)));
__device__ __forceinline__ float silu_fast(float a) { return a * __builtin_amdgcn_rcpf(1.0f + __builtin_amdgcn_exp2f(-1.44269504f * a)); }
struct EpiSwiglu {
    static constexpr bool PERM = true, AFTER_DRAIN = false;
    bf16_t* O; int ldc;
    __device__ __forceinline__ void operator()(const f32x4 (&acc)[2][2][4][2], const Unit& u, int wr, int wc, int fr, int fq) const {
        const int row0 = u.pm * BM + wr * 64 + fr, col0 = u.pn * HALF + wc * 32 + 8 * fq;
#pragma unroll
        for (int ai = 0; ai < 2; ++ai)
#pragma unroll
            for (int m = 0; m < 4; ++m) {
                bf16_t* rowp = O + (size_t)(row0 + ai * HALF + m * 16) * ldc + col0;
                const f32x4 a0 = acc[ai][0][m][0], a1 = acc[ai][0][m][1], b0 = acc[ai][1][m][0], b1 = acc[ai][1][m][1];
                f32x4 h0, h1;
#pragma unroll
                for (int j = 0; j < 4; ++j) { h0[j] = silu_fast(a0[j]) * b0[j]; h1[j] = silu_fast(a1[j]) * b1[j]; }
                u32x4 w; w.x = cvt_pk_bf16(h0[0], h0[1]); w.y = cvt_pk_bf16(h0[2], h0[3]); w.z = cvt_pk_bf16(h1[0], h1[1]); w.w = cvt_pk_bf16(h1[2], h1[3]);
                *(u32x4*)rowp = w;
            }
    }
};
struct EpiResid {
    static constexpr bool PERM = false, AFTER_DRAIN = false;
    float* xlat; float* xctx; const float* gate; float coef;
    __device__ __forceinline__ void operator()(const f32x4 (&acc)[2][2][4][2], const Unit& u, int wr, int wc, int fr, int fq) const {
        const int row0 = u.pm * BM + wr * 64 + fr, col0 = u.pn * BM + wc * 32 + 4 * fq;
        const int mr = (u.pm < 64) ? (u.pm >> 4) : 4;
        const float* gr = gate + (size_t)mr * NMODC + col0;
        float* xb = (u.pm < 64 ? xlat + (size_t)row0 * D : xctx + (size_t)(row0 - TL) * D) + col0;
#pragma unroll
        for (int bj = 0; bj < 2; ++bj)
#pragma unroll
            for (int n = 0; n < 2; ++n) {
                const f32x4 gv = *(const f32x4*)(gr + bj * HALF + n * 16) * coef;
#pragma unroll
                for (int ai = 0; ai < 2; ++ai)
#pragma unroll
                    for (int m = 0; m < 4; ++m) { float* q = xb + (size_t)(ai * HALF + m * 16) * D + bj * HALF + n * 16; f32x4 xv = *(const f32x4*)q; xv += gv * acc[ai][bj][m][n]; *(f32x4*)q = xv; }
                asm volatile("" ::: "memory");
            }
    }
};
struct EpiStoreF32 {
    static constexpr bool PERM = false, AFTER_DRAIN = false;
    float* C; int ldc;
    __device__ __forceinline__ void operator()(const f32x4 (&acc)[2][2][4][2], const Unit& u, int wr, int wc, int fr, int fq) const {
        const int row0 = u.pm * BM + wr * 64 + fr, col0 = u.pn * BM + wc * 32 + 4 * fq;
#pragma unroll
        for (int ai = 0; ai < 2; ++ai)
#pragma unroll
            for (int m = 0; m < 4; ++m) { float* rowp = C + (size_t)(row0 + ai * HALF + m * 16) * ldc + col0;
#pragma unroll
                for (int bj = 0; bj < 2; ++bj)
#pragma unroll
                    for (int n = 0; n < 2; ++n) *(f32x4*)(rowp + bj * HALF + n * 16) = acc[ai][bj][m][n]; }
    }
};
struct EpiStoreBf16 {
    static constexpr bool PERM = true, AFTER_DRAIN = false;
    bf16_t* O; int ldc;
    __device__ __forceinline__ void operator()(const f32x4 (&acc)[2][2][4][2], const Unit& u, int wr, int wc, int fr, int fq) const {
        const int row0 = u.pm * BM + wr * 64 + fr, col0 = u.pn * BM + wc * 32 + 8 * fq;
#pragma unroll
        for (int ai = 0; ai < 2; ++ai)
#pragma unroll
            for (int m = 0; m < 4; ++m) { bf16_t* rowp = O + (size_t)(row0 + ai * HALF + m * 16) * ldc + col0;
#pragma unroll
                for (int bj = 0; bj < 2; ++bj) { const f32x4 v0 = acc[ai][bj][m][0], v1 = acc[ai][bj][m][1];
                    u32x4 w; w.x = cvt_pk_bf16(v0[0], v0[1]); w.y = cvt_pk_bf16(v0[2], v0[3]); w.z = cvt_pk_bf16(v1[0], v1[1]); w.w = cvt_pk_bf16(v1[2], v1[3]);
                    *(u32x4*)(rowp + bj * HALF) = w; } }
    }
};
struct SliceOrder {
    int nslice, c;
    __device__ __forceinline__ bool next(int i, Unit& u) const { if (i > 0 || c >= 16 * nslice) return false; u.ks = c % nslice; const int q = c / nslice; u.pm = 64 + (q >> 2); u.pn = q & 3; return true; }
    __device__ __forceinline__ void a_ready(const Unit&) const {}
    __device__ __forceinline__ void done(const Unit&) const {}
};
struct EpiStorePart {
    static constexpr bool PERM = false, AFTER_DRAIN = false;
    float* part; int nslice;
    __device__ __forceinline__ void operator()(const f32x4 (&acc)[2][2][4][2], const Unit& u, int wr, int wc, int fr, int fq) const {
        int frr = fr, fqq = fq; asm volatile("" : "+v"(frr), "+v"(fqq));
        float* C = part + (size_t)((((u.pm - 64) * 4 + u.pn) * nslice + u.ks)) * 65536 + (size_t)(wr * 64 + frr) * 256 + wc * 32 + 4 * fqq;
#pragma unroll
        for (int ai = 0; ai < 2; ++ai)
#pragma unroll
            for (int m = 0; m < 4; ++m) { float* rowp = C + (size_t)(ai * HALF + m * 16) * 256;
#pragma unroll
                for (int bj = 0; bj < 2; ++bj)
#pragma unroll
                    for (int n = 0; n < 2; ++n) *(f32x4*)(rowp + bj * HALF + n * 16) = acc[ai][bj][m][n]; }
    }
};
template <class Epi, class Sched, bool STAMP = false>
__device__ __forceinline__ void gemm_phase(PG8_LAS unsigned char* lds, const Gemm g, const Sched& S, const Epi& E, unsigned long long* stamps) {
    int tid_raw = threadIdx.x; asm volatile("" : "+v"(tid_raw)); const int tid = tid_raw, wid = __builtin_amdgcn_readfirstlane(tid >> 6), lane = tid & 63, wr = wid >> 2, wc = wid & 3, fr = lane & 15, fq = lane >> 4;
    const int K = g.K, nt = K / BK, LD = g.ldk;
    int ts_lo = 0, ts_hi = 0, nts = 0; const unsigned long long rt_entry = STAMP ? (unsigned long long)wall_clock64() : 0ull;
#define PG8_STAMP() do { if (STAMP && wid == 0 && nts < 64) { const unsigned long long _c = (unsigned long long)clock64(); \
        ts_lo = (lane == nts) ? (int)(unsigned)_c : ts_lo; ts_hi = (lane == nts) ? (int)(unsigned)(_c >> 32) : ts_hi; ++nts; } } while (0)
    PG8_STAMP();
    unsigned voffA[2], voffB[2];
#pragma unroll
    for (int i = 0; i < 2; ++i) { int R, C; stage_rc(tid * 16 + i * 8192, R, C); const int Rb = Epi::PERM ? ((R & ~31) + perm32(R & 31)) : R;
        voffA[i] = (unsigned)(R * LD + C) * 2u; voffB[i] = (unsigned)(Rb * LD + C) * 2u; }
    const size_t kstep = (size_t)(BK * 2);
    const size_t hstep = (size_t)HALF * LD * 2;
    const size_t tstep = 2 * hstep;
    const unsigned ldsw = (unsigned)wid * 1024u;
    const int aoff = lds_byte(wr * 64 + fr, fq * 8), boff = lds_byte(wc * 32 + fr, fq * 8);
#define PG8_SA(b, h) (((b) * 2 + (h)) * HTB)
#define PG8_SB(b, h) ((4 + (b) * 2 + (h)) * HTB)
#define PG8_STAGE(bufoff, gbase, voff) do { _Pragma("unroll") for (int _i = 0; _i < 2; ++_i) \
        __builtin_amdgcn_global_load_lds((const unsigned*)((const char*)(gbase) + (voff)[_i]), (PG8_LAS unsigned*)(lds + (bufoff) + ldsw + _i * 8192), 16, 0, 0); } while (0)
#define PG8_LDA(dst, b, h) do { _Pragma("unroll") for (int m = 0; m < 4; ++m) _Pragma("unroll") for (int k = 0; k < 2; ++k) dst[m][k] = *(const PG8_LAS bf16x8*)(lds + PG8_SA(b, h) + aoff + m * 2048 + k * 1024); } while (0)
#define PG8_LDB(dst, b, h) do { _Pragma("unroll") for (int n = 0; n < 2; ++n) _Pragma("unroll") for (int k = 0; k < 2; ++k) dst[n][k] = *(const PG8_LAS bf16x8*)(lds + PG8_SB(b, h) + boff + n * 2048 + k * 1024); } while (0)
#define PG8_MMA(ai, bj, At, Bt) do { __builtin_amdgcn_s_setprio(1); _Pragma("unroll") for (int m = 0; m < 4; ++m) _Pragma("unroll") for (int n = 0; n < 2; ++n) _Pragma("unroll") for (int k = 0; k < 2; ++k) \
        acc[ai][bj][m][n] = __builtin_amdgcn_mfma_f32_16x16x32_bf16(Bt[n][k], At[m][k], acc[ai][bj][m][n], 0, 0, 0); __builtin_amdgcn_s_setprio(0); } while (0)
#define PG8_WAIT_V(n) asm volatile("s_waitcnt vmcnt(" #n ")" ::: "memory")
#define PG8_WAIT_L(n) asm volatile("s_waitcnt lgkmcnt(" #n ")" ::: "memory")
#define PG8_BAR __builtin_amdgcn_s_barrier()
#define PG8_SCHED __builtin_amdgcn_sched_barrier(0)
    Unit cur, nxt; int ui = 0;
    if (!S.next(0, cur)) return;
    f32x4 acc[2][2][4][2];
#pragma unroll
    for (int a = 0; a < 2; ++a)
#pragma unroll
        for (int b = 0; b < 2; ++b)
#pragma unroll
            for (int m = 0; m < 4; ++m)
#pragma unroll
                for (int n = 0; n < 2; ++n) acc[a][b][m][n] = (f32x4){0.f, 0.f, 0.f, 0.f};
    bf16x8 At[4][2], B0[2][2], B1[2][2];
    const char* cA = (const char*)g.A + (size_t)cur.pm * tstep + (size_t)cur.ks * K * 2; const char* cB = (const char*)g.Bt + (size_t)cur.pn * tstep + (size_t)cur.ks * K * 2;
    S.a_ready(cur);
    PG8_STAGE(PG8_SB(0, 0), cB, voffB); PG8_STAGE(PG8_SA(0, 0), cA, voffA); PG8_STAGE(PG8_SB(0, 1), cB + hstep, voffB); PG8_STAGE(PG8_SA(0, 1), cA + hstep, voffA);
    if (wr == 1) PG8_BAR;
    PG8_WAIT_V(4); PG8_BAR;
    PG8_STAGE(PG8_SB(1, 0), cB + kstep, voffB); PG8_STAGE(PG8_SA(1, 0), cA + kstep, voffA); PG8_STAGE(PG8_SB(1, 1), cB + hstep + kstep, voffB);
    PG8_WAIT_V(6); PG8_BAR;
    PG8_STAMP();
    for (;;) {
        const bool has_next = S.next(ui + 1, nxt);
        const char* nA = has_next ? (const char*)g.A + (size_t)nxt.pm * tstep + (size_t)nxt.ks * K * 2 : cA; const char* nB = has_next ? (const char*)g.Bt + (size_t)nxt.pn * tstep + (size_t)nxt.ks * K * 2 : cB;
        for (int t = 0; t < nt; t += 2) {
            const bool last = (t == nt - 2);
            const char* a1 = cA + (size_t)(t + 1) * kstep;
            const char* a2 = last ? nA : cA + (size_t)(t + 2) * kstep; const char* b2 = last ? nB : cB + (size_t)(t + 2) * kstep;
            const char* a3 = a2 + kstep; const char* b3 = b2 + kstep;
            if (last && has_next) S.a_ready(nxt);
            PG8_LDB(B0, 0, 0); PG8_SCHED; PG8_LDA(At, 0, 0); PG8_STAGE(PG8_SA(1, 1), a1 + hstep, voffA);
            PG8_WAIT_L(8); PG8_BAR; PG8_WAIT_L(0); PG8_MMA(0, 0, At, B0); PG8_BAR; PG8_SCHED;
            PG8_LDB(B1, 0, 1); PG8_STAGE(PG8_SB(0, 0), b2, voffB);
            PG8_BAR; PG8_WAIT_L(0); PG8_MMA(0, 1, At, B1); PG8_BAR;
            PG8_LDA(At, 0, 1); PG8_STAGE(PG8_SA(0, 0), a2, voffA);
            PG8_BAR; PG8_WAIT_L(0); PG8_MMA(1, 0, At, B0); PG8_BAR; PG8_SCHED;
            PG8_STAGE(PG8_SB(0, 1), b2 + hstep, voffB);
            PG8_WAIT_V(6); PG8_BAR; PG8_MMA(1, 1, At, B1); PG8_BAR;
            PG8_LDB(B0, 1, 0); PG8_SCHED; PG8_LDA(At, 1, 0); PG8_STAGE(PG8_SA(0, 1), a2 + hstep, voffA);
            PG8_WAIT_L(8); PG8_BAR; PG8_WAIT_L(0); PG8_MMA(0, 0, At, B0); PG8_BAR; PG8_SCHED;
            PG8_LDB(B1, 1, 1); PG8_STAGE(PG8_SB(1, 0), b3, voffB);
            PG8_BAR; PG8_WAIT_L(0); PG8_MMA(0, 1, At, B1); PG8_BAR;
            PG8_LDA(At, 1, 1); PG8_STAGE(PG8_SA(1, 0), a3, voffA);
            PG8_BAR; PG8_WAIT_L(0); PG8_MMA(1, 0, At, B0); PG8_BAR; PG8_SCHED;
            PG8_STAGE(PG8_SB(1, 1), b3 + hstep, voffB);
            PG8_WAIT_V(6); PG8_BAR; PG8_MMA(1, 1, At, B1); PG8_BAR;
        }
        PG8_STAMP();
        if constexpr (!Epi::AFTER_DRAIN) { E(acc, cur, wr, wc, fr, fq); S.done(cur); }
        PG8_STAMP();
        if (!has_next) break;
#pragma unroll
        for (int a = 0; a < 2; ++a)
#pragma unroll
            for (int b = 0; b < 2; ++b)
#pragma unroll
                for (int m = 0; m < 4; ++m)
#pragma unroll
                    for (int n = 0; n < 2; ++n) acc[a][b][m][n] = (f32x4){0.f, 0.f, 0.f, 0.f};
        cur = nxt; cA = nA; cB = nB; ++ui;
    }
    PG8_WAIT_V(0);
    if (wr == 0) PG8_BAR;
    PG8_BAR;
    if constexpr (Epi::AFTER_DRAIN) { E.fused(acc, cur, wr, wc, fr, fq, lds, wid, lane); S.done(cur); }
    PG8_STAMP();
    if (STAMP && wid == 0) { stamps[lane] = lane < nts ? (((unsigned long long)(unsigned)ts_hi << 32) | (unsigned)ts_lo) : 0ull;
        if (lane == 62) stamps[62] = rt_entry; if (lane == 63) stamps[63] = (unsigned long long)wall_clock64(); }
#undef PG8_STAMP
#undef PG8_SA
#undef PG8_SB
#undef PG8_STAGE
#undef PG8_LDA
#undef PG8_LDB
#undef PG8_MMA
#undef PG8_WAIT_V
#undef PG8_WAIT_L
#undef PG8_BAR
#undef PG8_SCHED
}
}
#define LAS __attribute__((address_space(3)))
typedef unsigned short bf16_t;
using pg8::f32x4; using pg8::u32x4; using pg8::bf16x8; using pg8::cvt_pk_bf16;
typedef float f32x2 __attribute__((ext_vector_type(2)));
typedef unsigned u32x2 __attribute__((ext_vector_type(2)));
#define LDS_WAIT() asm volatile("s_waitcnt lgkmcnt(0)" ::: "memory")

enum { I_X = 0, I_C, I_CTX, I_CCTX, I_NORMG, I_WMOD, I_BMOD, I_FFNIN, I_FFNOUT, I_WIN, I_WOUT, I_GLA_WDEC, I_GLA_BDEC, I_GLA_NORM,
       I_SSM_CONVW, I_SSM_CONVB, I_SSM_DTB, I_SSM_ALOG, I_SSM_D, I_SSM_NORM, I_RW_MU, I_RW_W0, I_RW_WDEC, I_RW_A0, I_RW_WA, I_RW_WG,
       I_RW_KK, I_RW_KA, I_RW_RK, I_RW_LNG, I_RW_LNB, I_ATT_QN, I_ATT_KN, N_INPUTS };
struct Params { const float* in[N_INPUTS]; float* out; unsigned char* ws; int ph_lo, ph_hi; };

constexpr size_t al256(size_t x) { return (x + 255) & ~(size_t)255; }
constexpr size_t WS_WUP = 0;
constexpr size_t WS_WDN = WS_WUP + al256((size_t)2 * NUP * D * 2);
constexpr size_t WS_WIN = WS_WDN + al256((size_t)2 * D * DFF * 2);
constexpr size_t WS_WOUT = WS_WIN + al256((size_t)NINP * D * 2);
constexpr size_t WS_MOD = WS_WOUT + al256((size_t)D * D * 2);
constexpr size_t WS_XCTX = WS_MOD + al256((size_t)DEPTH * 5 * NMODC * 4);
constexpr size_t WS_HID = WS_XCTX + al256((size_t)TC * D * 4);
constexpr size_t WS_HA = WS_HID + al256((size_t)T * DFF * 2);
constexpr size_t WS_RW = WS_HID;
constexpr size_t WS_U = WS_HA + al256((size_t)T * D * 2);
constexpr size_t WS_G = WS_U + al256((size_t)T * NINP * 2);
constexpr size_t WS_DEC = WS_G + al256((size_t)T * 256 * 4);
constexpr size_t WS_XBC = WS_DEC + al256((size_t)T * 256 * 4);
constexpr size_t WS_DT = WS_XBC + al256((size_t)T * 512 * 4);
constexpr size_t WS_ATTQ = WS_DT + al256((size_t)T * 16 * 4);
constexpr size_t WS_ATTK = WS_ATTQ + al256((size_t)T * 256 * 2);
constexpr size_t WS_ATTVT = WS_ATTK + al256((size_t)T * 128 * 2);
constexpr size_t WS_Y = WS_ATTVT + al256((size_t)T * 128 * 2);
constexpr size_t WS_Y2 = WS_Y + al256((size_t)3 * T * 256 * 4);
constexpr int NSEG = 68, NCHAIN = 32;
constexpr size_t WS_RWE = WS_Y2 + al256((size_t)3 * T * 256 * 4);
constexpr size_t WS_RWP = WS_RWE + al256((size_t)NCHAIN * NSEG * 4096 * 4);
constexpr size_t WS_SSE = WS_RWP + al256((size_t)NCHAIN * NSEG * 4096 * 4);
constexpr size_t WS_GLE = WS_SSE + al256((size_t)NCHAIN * NSEG * 4096 * 4);
constexpr size_t WS_ZRW = WS_GLE + al256((size_t)NCHAIN * NSEG * 2048 * 4);
constexpr size_t WS_ZSS = WS_ZRW + al256((size_t)2 * T * 256 * 4);
constexpr size_t WS_CAT = WS_ZRW;
constexpr size_t WS_ATTO = WS_U - (size_t)T * 256 * 2;
constexpr size_t WS_ZGL = WS_ZSS + al256((size_t)2 * T * 256 * 4);
constexpr size_t WS_SDEC = WS_ZGL + al256((size_t)2 * T * 128 * 4);
constexpr size_t WS_GDEC = WS_SDEC + al256((size_t)NCHAIN * NSEG * 4);
constexpr size_t WS_BAR = WS_GDEC + al256((size_t)NCHAIN * NSEG * 32 * 4);
constexpr size_t WS_END = WS_BAR + 16384;
static_assert((size_t)T * 4 * 7 * 64 * 4 <= (WS_ATTO - WS_HID), "RWKV streams + attention output must fit the hid|hA region");
static_assert((size_t)T * D * 2 <= (size_t)2 * T * 256 * 4 && WS_END <= (size_t)738000000, "workspace budget");
constexpr int LDS_BYTES = 131072 + 1024;
constexpr int NKEY = SEQ + CTXL;

struct Frame { LAS unsigned char* lds; int tid, lane, wave, bid, nblk; };

__device__ __forceinline__ float wave_sum(float v) {
#pragma unroll
    for (int o = 1; o < 64; o <<= 1) v += __shfl_xor(v, o);
    return v;
}
__device__ __forceinline__ float sum16(float v) { v += __shfl_xor(v, 1); v += __shfl_xor(v, 2); v += __shfl_xor(v, 4); v += __shfl_xor(v, 8); return v; }
__device__ __forceinline__ float sigmoid_f(float x) { return 1.0f / (1.0f + expf(-x)); }
__device__ __forceinline__ float silu_f(float x) { return x * sigmoid_f(x); }
__device__ __forceinline__ float sigmoid_fast(float x) { return __builtin_amdgcn_rcpf(1.0f + __expf(-x)); }
__device__ __forceinline__ float silu_fast2(float x) { return x * sigmoid_fast(x); }
__device__ __forceinline__ float softplus_f(float x) { return fmaxf(x, 0.f) + log1pf(expf(-fabsf(x))); }
__device__ __forceinline__ float bf2f(bf16_t x) { return __uint_as_float((unsigned)x << 16); }
__device__ __forceinline__ f32x4 ldbf4(const bf16_t* q) { const u32x2 w = *(const u32x2*)q; f32x4 o; o.x = __uint_as_float(w.x << 16); o.y = __uint_as_float(w.x & 0xffff0000u); o.z = __uint_as_float(w.y << 16); o.w = __uint_as_float(w.y & 0xffff0000u); return o; }
__device__ __forceinline__ int modrow_of(int r) { return r < TL ? (r >> 12) : 4; }
__device__ __forceinline__ void seq_of(int r, int& pos, int& len) { if (r < TL) { pos = r & (SEQ - 1); len = SEQ; } else { pos = (r - TL) & (CTXL - 1); len = CTXL; } }
__device__ __forceinline__ float* xrow_of(const Params& p, int r) { return r < TL ? p.out + (size_t)r * D : (float*)(p.ws + WS_XCTX) + (size_t)(r - TL) * D; }

__device__ __forceinline__ void conv_item(const float* __restrict__ W, int ldw, int srclimit, int srccol0, int k0, bf16_t* dst, int K, LAS float* scr, int lane) {
    { float tv[32]; const int j = lane & 31, sc = srccol0 + j; const bool ok = sc < srclimit; const float* wp = W + (size_t)(k0 + (lane >> 5)) * ldw + sc;
#pragma unroll
      for (int i = 0; i < 32; ++i) tv[i] = ok ? wp[(size_t)(2 * i) * ldw] : 0.f;
#pragma unroll
      for (int i = 0; i < 32; ++i) scr[(2 * i + (lane >> 5)) * 33 + j] = tv[i]; }
    LDS_WAIT();
    const int c = lane & 7;
#pragma unroll
    for (int jj = 0; jj < 4; ++jj) { const int n = (lane >> 3) + 8 * jj; const LAS float* s = scr + (8 * c) * 33 + n;
        u32x4 o; o.x = cvt_pk_bf16(s[0], s[33]); o.y = cvt_pk_bf16(s[66], s[99]); o.z = cvt_pk_bf16(s[132], s[165]); o.w = cvt_pk_bf16(s[198], s[231]);
        *(u32x4*)(dst + (size_t)n * K + k0 + 8 * c) = o; }
    LDS_WAIT();
}
__device__ __forceinline__ void phase_conv(const Params& p, const Frame& F, int l, int mask, int gw, int NGW) {
    LAS float* scr = (LAS float*)(F.lds + F.wave * 8448);
    bf16_t* wup = (bf16_t*)(p.ws + WS_WUP); bf16_t* wdn = (bf16_t*)(p.ws + WS_WDN); bf16_t* win = (bf16_t*)(p.ws + WS_WIN); bf16_t* wout = (bf16_t*)(p.ws + WS_WOUT);
    constexpr int I_UP = 16 * 176, I_DN = 44 * 32, I_INW = 16 * 104, I_OUTW = 16 * 32;
    const int n0_ = (mask & 1) ? I_UP : 0, n1_ = (mask & 2) ? I_UP : 0, n2_ = (mask & 4) ? I_DN : 0, n3_ = (mask & 8) ? I_DN : 0, n4_ = (mask & 16) ? I_INW : 0, n5_ = (mask & 32) ? I_OUTW : 0;
    const int NITEMS = n0_ + n1_ + n2_ + n3_ + n4_ + n5_;
    for (int it = gw; it < NITEMS; it += NGW) {
        int r = it;
        if (r < n0_ + n1_) { const int f = (r < n0_) ? 0 : 1; r -= (f && n0_) ? n0_ : 0; const int kb = r / 176, nb = r % 176, n0 = 32 * nb, pn = n0 >> 8, bj = (n0 >> 7) & 1, j0 = n0 & 127;
            conv_item(p.in[I_FFNIN] + (size_t)(l * 2 + f) * D * NUP, NUP, NUP, bj * DFF + 128 * pn + j0, 64 * kb, wup + (size_t)f * NUP * D + (size_t)n0 * D, D, scr, F.lane); continue; }
        r -= n0_ + n1_;
        if (r < n2_ + n3_) { const int f = (r < n2_) ? 0 : 1; r -= (f && n2_) ? n2_ : 0; const int kb = r / 32, nb = r % 32, n0 = 32 * nb;
            conv_item(p.in[I_FFNOUT] + (size_t)(l * 2 + f) * DFF * D, D, D, n0, 64 * kb, wdn + (size_t)f * D * DFF + (size_t)n0 * DFF, DFF, scr, F.lane); continue; }
        r -= n2_ + n3_;
        if (r < n4_) { const int kb = r / 104, nb = r % 104, n0 = 32 * nb;
            conv_item(p.in[I_WIN] + (size_t)l * D * NIN, NIN, NIN, n0, 64 * kb, win + (size_t)n0 * D, D, scr, F.lane); continue; }
        r -= n4_;
        { const int kb = r / 32, nb = r % 32, n0 = 32 * nb;
            conv_item(p.in[I_WOUT] + (size_t)l * D * D, D, D, n0, 64 * kb, wout + (size_t)n0 * D, D, scr, F.lane); }
    }
}
__device__ __forceinline__ void phase_mod_init(const Params& p, const Frame& F) {
    LAS float* sc = (LAS float*)F.lds; LAS float* part = sc + 5 * D;
    for (int i = F.tid; i < 5 * D; i += 512) { const int r = i >> 10, k = i & 1023; const float cv = r < 4 ? p.in[I_C][r * D + k] : p.in[I_CCTX][k]; sc[i] = silu_f(cv); }
    __syncthreads();
    float* mod = (float*)(p.ws + WS_MOD);
    for (int item = F.bid; item < DEPTH * 144; item += F.nblk) {
        const int l = item / 144, cb = item % 144;
        const float* W = p.in[I_WMOD] + (size_t)l * D * NMODC + cb * 64 + F.lane;
        float a0 = 0.f, a1 = 0.f, a2 = 0.f, a3 = 0.f, a4 = 0.f;
#pragma unroll 8
        for (int k = F.wave * 128; k < F.wave * 128 + 128; ++k) { const float w = W[(size_t)k * NMODC]; a0 += sc[k] * w; a1 += sc[D + k] * w; a2 += sc[2 * D + k] * w; a3 += sc[3 * D + k] * w; a4 += sc[4 * D + k] * w; }
        part[(F.wave * 5 + 0) * 64 + F.lane] = a0; part[(F.wave * 5 + 1) * 64 + F.lane] = a1; part[(F.wave * 5 + 2) * 64 + F.lane] = a2; part[(F.wave * 5 + 3) * 64 + F.lane] = a3; part[(F.wave * 5 + 4) * 64 + F.lane] = a4;
        __syncthreads();
        if (F.tid < 320) { const int r = F.tid >> 6, ln = F.tid & 63; float s = p.in[I_BMOD][l * NMODC + cb * 64 + ln];
#pragma unroll
            for (int w = 0; w < 8; ++w) s += part[(w * 5 + r) * 64 + ln];
            mod[(size_t)(l * 5 + r) * NMODC + cb * 64 + ln] = s; }
        __syncthreads();
    }
    const f32x4* xs = (const f32x4*)p.in[I_X]; f32x4* xd = (f32x4*)p.out;
    for (size_t i = (size_t)F.bid * 512 + F.tid; i < (size_t)TL * D / 4; i += (size_t)F.nblk * 512) xd[i] = xs[i];
    const f32x4* cs = (const f32x4*)p.in[I_CTX]; f32x4* cd = (f32x4*)(p.ws + WS_XCTX);
    for (size_t i = (size_t)F.bid * 512 + F.tid; i < (size_t)TC * D / 4; i += (size_t)F.nblk * 512) cd[i] = cs[i];
}
__device__ __forceinline__ void nm_rows(const Params& p, const Frame& F, const float* mod, const float* g, int lo, int hi, int pns, const float* pgate, float pcoef) {
    bf16_t* hA = (bf16_t*)(p.ws + WS_HA);
    f32x4 gs[4], sh[4]; int curmr = -1;
    for (int r = lo; r < hi; r += 8) {
        f32x4 v[8][4];
#pragma unroll
        for (int k = 0; k < 8; ++k) { const int rr = r + k < hi ? r + k : hi - 1; const float* xr = xrow_of(p, rr);
#pragma unroll
            for (int j = 0; j < 4; ++j) v[k][j] = *(const f32x4*)(xr + 4 * F.lane + 256 * j); }
        if (pns > 0) {
            const float* part = (const float*)(p.ws + WS_U);
#pragma unroll
            for (int k = 0; k < 8; ++k) { const int rr = r + k; if (rr < hi) { const int rc = rr - TL, pmq = rc >> 8, rit = rc & 255; float* xr = xrow_of(p, rr);
#pragma unroll
                for (int j = 0; j < 4; ++j) { f32x4 s4 = {0.f, 0.f, 0.f, 0.f}; const float* pp = part + (size_t)((pmq * 4 + j) * pns) * 65536 + (size_t)rit * 256 + 4 * F.lane;
                    if (pns == 11) { f32x4 pv[11];
#pragma unroll
                        for (int sl = 0; sl < 11; ++sl) pv[sl] = *(const f32x4*)(pp + (size_t)sl * 65536);
#pragma unroll
                        for (int sl = 0; sl < 11; ++sl) s4 += pv[sl]; }
                    else { f32x4 pv[4];
#pragma unroll
                        for (int sl = 0; sl < 4; ++sl) pv[sl] = sl < pns ? *(const f32x4*)(pp + (size_t)sl * 65536) : (f32x4){0.f, 0.f, 0.f, 0.f};
#pragma unroll
                        for (int sl = 0; sl < 4; ++sl) s4 += pv[sl]; }
                    v[k][j] += *(const f32x4*)(pgate + 4 * F.lane + 256 * j) * pcoef * s4; *(f32x4*)(xr + 4 * F.lane + 256 * j) = v[k][j]; } } }
        }
#pragma unroll
        for (int k = 0; k < 8; ++k) { const int rr = r + k; if (rr < hi) {
            const int mr = modrow_of(rr);
            if (mr != curmr) { curmr = mr; const float* shp = mod + (size_t)mr * NMODC;
#pragma unroll
                for (int j = 0; j < 4; ++j) { sh[j] = *(const f32x4*)(shp + 4 * F.lane + 256 * j); gs[j] = (*(const f32x4*)(shp + D + 4 * F.lane + 256 * j) + 1.0f) * *(const f32x4*)(g + 4 * F.lane + 256 * j); } }
            float ss = 0.f;
#pragma unroll
            for (int j = 0; j < 4; ++j) ss += (v[k][j].x * v[k][j].x + v[k][j].y * v[k][j].y) + (v[k][j].z * v[k][j].z + v[k][j].w * v[k][j].w);
            const float rstd = 1.0f / sqrtf(wave_sum(ss) * (1.0f / D) + 1e-6f);
#pragma unroll
            for (int j = 0; j < 4; ++j) { const f32x4 o = v[k][j] * rstd * gs[j] + sh[j];
                u32x2 w; w.x = cvt_pk_bf16(o.x, o.y); w.y = cvt_pk_bf16(o.z, o.w); *(u32x2*)(hA + (size_t)rr * D + 4 * F.lane + 256 * j) = w; } } }
    }
}
__device__ __forceinline__ void phase_normmod(const Params& p, const Frame& F, int l, int which, int nrows, int pns, const float* pgate, float pcoef) {
    const float* mod = (const float*)(p.ws + WS_MOD) + (size_t)(l * 5) * NMODC + (3 * which) * D;
    const float* g = p.in[I_NORMG] + (size_t)(l * 3 + which) * D;
    const int nw = F.nblk * 8, gw = F.bid * 8 + F.wave;
    nm_rows(p, F, mod, g, (int)(((long)gw * TL) / nw), (int)(((long)(gw + 1) * TL) / nw), 0, pgate, pcoef);
    if (nrows == T) nm_rows(p, F, mod, g, TL + (int)(((long)gw * TC) / nw), TL + (int)(((long)(gw + 1) * TC) / nw), pns, pgate, pcoef);
}
#define XB_TMO      128
#define XB_XCNT(j)  (256  + 64 * (j))
#define XB_XSUB(j)  (1280 + 64 * (j))
#define XB_XGEN(j)  (2304 + 64 * (j))
#define XB_TOP      3328
#define XB_TOPGEN   3392
#define XCD_BAR_WORDS 3456
#define XB_SPIN_CAP (1u << 18)

__device__ __forceinline__ unsigned xb_ld(unsigned* p)              { return __hip_atomic_load(p, __ATOMIC_RELAXED, __HIP_MEMORY_SCOPE_AGENT); }
__device__ __forceinline__ unsigned xb_add(unsigned* p, unsigned v) { return __hip_atomic_fetch_add(p, v, __ATOMIC_RELAXED, __HIP_MEMORY_SCOPE_AGENT); }
__device__ __forceinline__ unsigned xb_xcc_id() { return (unsigned)__builtin_amdgcn_s_getreg((3 << 11) | 20) & 0xFu; }
#define XB_SPIN(cond, bar) do { unsigned _sp = 0; while (cond) { __builtin_amdgcn_s_sleep(1); \
    if ((++_sp & 255u) == 0u) { if (xb_ld(&(bar)[XB_TMO])) break; if (_sp > XB_SPIN_CAP) { atomicAdd(&(bar)[XB_TMO], 1u); break; } } } } while (0)

struct XcdBarrier {
    unsigned* bar; unsigned x;
    volatile LAS unsigned* st;
};

__device__ __forceinline__ XcdBarrier xcd_barrier_post(unsigned* bar, volatile LAS unsigned* st) {
    XcdBarrier b; b.bar = bar; b.x = xb_xcc_id(); b.st = st;
    if (threadIdx.x == 0) (void)xb_add(&bar[XB_XCNT(b.x)], 1u);
    return b;
}
__device__ __forceinline__ void xcd_barrier_complete(unsigned* bar, unsigned x, unsigned& nloc, unsigned& nx) {
    const unsigned G = gridDim.x * gridDim.y * gridDim.z;
    unsigned sum, cnt, mine, sp = 0u;
    for (;;) {
        sum = 0u; cnt = 0u; mine = 0u;
#pragma unroll
        for (unsigned j = 0; j < 16; ++j) { const unsigned c = xb_ld(&bar[XB_XCNT(j)]); sum += c; cnt += (c > 0u) ? 1u : 0u; mine = (j == x) ? c : mine; }
        if (sum == G) break;
        __builtin_amdgcn_s_sleep(1);
        if ((++sp & 255u) == 0u) { if (xb_ld(&bar[XB_TMO])) break; if (sp > XB_SPIN_CAP) { atomicAdd(&bar[XB_TMO], 1u); break; } }
    }
    nloc = mine > 0u ? mine : 1u; nx = cnt > 0u ? cnt : 1u;
}

__device__ __forceinline__ void xcd_barrier(const XcdBarrier& b) {
    asm volatile("s_waitcnt vmcnt(0)" ::: "memory");
    __syncthreads();
    if (threadIdx.x == 0) {
        unsigned* bar = b.bar;
        __builtin_amdgcn_s_waitcnt(0);
        unsigned nloc = b.st[0], nx = b.st[1];
        if (nloc == 0u) { xcd_barrier_complete(bar, b.x, nloc, nx); b.st[0] = nloc; b.st[1] = nx; }
        const unsigned old = xb_add(&bar[XB_XSUB(b.x)], 1u);
        const unsigned gen = old / nloc;
        if (old + 1u == (gen + 1u) * nloc) {
            __builtin_amdgcn_fence(__ATOMIC_RELEASE, "agent");
            asm volatile("s_waitcnt vmcnt(0)" ::: "memory");
            const unsigned og = xb_add(&bar[XB_TOP], 1u);
            const unsigned tg = og / nx;
            if (og + 1u == (tg + 1u) * nx) xb_add(&bar[XB_TOPGEN], 1u);
            else XB_SPIN(xb_ld(&bar[XB_TOPGEN]) == tg, bar);
            __builtin_amdgcn_fence(__ATOMIC_ACQUIRE, "agent");
            xb_add(&bar[XB_XGEN(b.x)], 1u);
            asm volatile("s_waitcnt vmcnt(0)" ::: "memory");
        } else {
            XB_SPIN(xb_ld(&bar[XB_XGEN(b.x)]) == gen, bar);
            __builtin_amdgcn_fence(__ATOMIC_ACQUIRE, "agent");
            asm volatile("s_waitcnt vmcnt(0)" ::: "memory");
        }
    }
    __syncthreads();
}
constexpr int U_GLA_Q = 0, U_GLA_K = 128, U_GLA_V = 256, U_GLA_G = 512, U_GLA_LR = 768;
constexpr int U_SSM_Z = 784, U_SSM_XBC = 1040, U_SSM_DT = 1552;
constexpr int U_RW = 1556;
constexpr int U_ATT_Q = 2580, U_ATT_K = 2836, U_ATT_V = 2964;

__device__ __forceinline__ void phase_prep(const Params& p, const Frame& F, int l) {
    const bf16_t* U = (const bf16_t*)(p.ws + WS_U);
    const size_t gtid = (size_t)F.bid * 512 + F.tid, gstride = (size_t)F.nblk * 512;
    { float* dec = (float*)(p.ws + WS_DEC); const float* wdec = p.in[I_GLA_WDEC] + (size_t)l * 2 * 16 * 128; const float* bdec = p.in[I_GLA_BDEC] + (size_t)l * 2 * 128;
      const int dc = (int)(gtid & 255), d = dc >> 7, c = dc & 127, tstep = (int)(gstride >> 8);
      float wv[16];
#pragma unroll
      for (int k = 0; k < 16; ++k) wv[k] = wdec[(d * 16 + k) * 128 + c];
      const float bz = bdec[d * 128 + c];
      for (int t = (int)(gtid >> 8); t < T; t += 4 * tstep) {
          u32x4 l0[4], l1[4];
#pragma unroll
          for (int k4 = 0; k4 < 4; ++k4) { const int tt = t + k4 * tstep; if (tt < T) { const bf16_t* lr = U + (size_t)tt * NINP + U_GLA_LR; l0[k4] = *(const u32x4*)lr; l1[k4] = *(const u32x4*)(lr + 8); } else { l0[k4] = (u32x4){0u, 0u, 0u, 0u}; l1[k4] = l0[k4]; } }
#pragma unroll
          for (int k4 = 0; k4 < 4; ++k4) { const int tt = t + k4 * tstep; if (tt < T) { float z = bz;
#pragma unroll
              for (int k = 0; k < 4; ++k) { z += __uint_as_float(l0[k4][k] << 16) * wv[2 * k] + __uint_as_float(l0[k4][k] & 0xffff0000u) * wv[2 * k + 1]; z += __uint_as_float(l1[k4][k] << 16) * wv[8 + 2 * k] + __uint_as_float(l1[k4][k] & 0xffff0000u) * wv[8 + 2 * k + 1]; }
              dec[(size_t)tt * 256 + dc] = __expf(-__logf(1.0f + __expf(-z)) * (1.0f / 16.0f)); } }
      } }
    { float* xbc = (float*)(p.ws + WS_XBC); const float* cw = p.in[I_SSM_CONVW] + (size_t)l * 3 * 512; const float* cb = p.in[I_SSM_CONVB] + (size_t)l * 512;
      { const int ch = (int)(gtid & 511), tstep = (int)(gstride >> 9); const float w0c = cw[ch], w1c = cw[512 + ch], w2c = cw[1024 + ch], bc = cb[ch];
        for (int t = (int)(gtid >> 9); t < T; t += 8 * tstep) {
            float cv[8], pv[8], nv[8];
#pragma unroll
            for (int k = 0; k < 8; ++k) { const int tt = t + k * tstep; cv[k] = 0.f; pv[k] = 0.f; nv[k] = 0.f;
                if (tt < T) { int pos, len; seq_of(tt, pos, len); const bf16_t* ur = U + (size_t)tt * NINP + U_SSM_XBC + ch; cv[k] = bf2f(ur[0]); if (pos > 0) pv[k] = bf2f(ur[-NINP]); if (pos < len - 1) nv[k] = bf2f(ur[NINP]); } }
#pragma unroll
            for (int k = 0; k < 8; ++k) { const int tt = t + k * tstep; if (tt < T) xbc[(size_t)tt * 512 + ch] = silu_fast2(bc + w1c * cv[k] + w0c * pv[k] + w2c * nv[k]); }
        } }
      float* dtb = (float*)(p.ws + WS_DT); const float* bias = p.in[I_SSM_DTB] + l * 8; const float* alog = p.in[I_SSM_ALOG] + l * 8;
      for (size_t i = gtid; i < (size_t)T * 8; i += gstride) { const int t = (int)(i >> 3), dh = (int)(i & 7), h = dh & 3;
          const float dtv = softplus_f(bf2f(U[(size_t)t * NINP + U_SSM_DT + h]) + bias[dh]);
          dtb[(size_t)t * 16 + dh] = dtv; dtb[(size_t)t * 16 + 8 + dh] = expf(-dtv * expf(alog[dh])); } }
    { bf16_t* aq = (bf16_t*)(p.ws + WS_ATTQ); bf16_t* ak = (bf16_t*)(p.ws + WS_ATTK); bf16_t* avt = (bf16_t*)(p.ws + WS_ATTVT);
      const float qn = p.in[I_ATT_QN][l * 64 + F.lane], kn = p.in[I_ATT_KN][l * 64 + F.lane];
      const int dd = F.lane, axis = dd >> 5, half = (dd >> 4) & 1, fi = dd & 15;
      const float inv = exp2f(-(float)fi * 0.8304820237218406f);
#ifndef REP_D
#define REP_D 1
#endif
      for (int rep_d = 0; rep_d < REP_D; ++rep_d)
      for (int t = F.bid * 8 + F.wave; t < T; t += F.nblk * 8) {
          const bf16_t* ur = U + (size_t)t * NINP; const bool lat = t < TL; int pos, len; seq_of(t, pos, len);
          const int b = lat ? (t >> 12) : ((t - TL) >> 8); const int key = lat ? pos : SEQ + pos;
          float cs = 1.f, sn = 0.f;
          if (lat) { const float ang = (float)(axis == 0 ? (pos >> 6) : (pos & 63)) * inv; const float kq = rintf(ang * 0.15915494309189535f);
              float rr = fmaf(-kq, 6.28125f, ang); rr = fmaf(-kq, 1.9353071795864769e-3f, rr); cs = cosf(rr); sn = sinf(rr); }
          bf16_t raw[8];
#pragma unroll
          for (int hh = 0; hh < 8; ++hh) raw[hh] = ur[U_ATT_Q + hh * 64 + dd];
#pragma unroll
          for (int hh = 0; hh < 6; ++hh) {
              const float v = bf2f(raw[hh]);
              const float ss = wave_sum(v * v); float n = v * (1.0f / sqrtf(ss * (1.0f / 64.0f) + 1e-6f)) * (hh < 4 ? qn : kn);
              const float pr = __shfl_xor(n, 16);
              n = n * cs + (half ? pr * sn : -pr * sn);
              if (hh < 4) { aq[(size_t)t * 256 + hh * 64 + dd] = (bf16_t)(cvt_pk_bf16(n * 0.18033688011112042f, 0.f) & 0xffffu); }
              else { ak[((size_t)(b * 2 + (hh - 4)) * NKEY + key) * 64 + dd] = (bf16_t)(cvt_pk_bf16(n, 0.f) & 0xffffu); }
          }
#pragma unroll
          for (int hh = 0; hh < 2; ++hh) { avt[((size_t)(b * 2 + hh) * 64 + dd) * NKEY + key] = raw[6 + hh]; }
      } }
    { float* S = (float*)(p.ws + WS_RW); float* G = (float*)(p.ws + WS_G);
      const float* mu0 = p.in[I_RW_MU] + (size_t)l * 2 * 1024; const float* mu1 = mu0 + 1024;
      const float* w0 = p.in[I_RW_W0] + (size_t)l * 2 * 256; const float* wdec = p.in[I_RW_WDEC] + (size_t)l * 2 * 64 * 256;
      const float* wa = p.in[I_RW_WA] + (size_t)l * 64 * 256; const float* wg = p.in[I_RW_WG] + (size_t)l * 128 * 256;
      LAS unsigned char* WT = F.lds;
      LAS unsigned char* inb = F.lds + 110592;
      LAS float* red = (LAS float*)(F.lds + 110592 + 4352);
      const int lr = F.lane & 15, lq = F.lane >> 4, hh = F.wave >> 1;
#ifndef REP_C
#define REP_C 1
#endif
      for (int rep_c = 0; rep_c < REP_C; ++rep_c) {
      __syncthreads();
      for (int idx = F.tid; idx < 3 * 32 * 256; idx += 512) { const int q = idx / 8192, rem = idx % 8192, kp = rem >> 8, n = rem & 255; const float* src = q == 0 ? wa : (q == 1 ? wdec : wdec + 64 * 256);
          *(LAS unsigned*)(WT + q * 36864 + n * 144 + kp * 4) = cvt_pk_bf16(src[(2 * kp) * 256 + n], src[(2 * kp + 1) * 256 + n]); }
      float a0c[2], kkc[2], kac[2], w00[2], w01[2], m0r[2], m1r[2], m0k[2], m1k[2], m0v[2], m1v[2];
#pragma unroll
      for (int jt = 0; jt < 2; ++jt) { const int c = 32 * F.wave + 16 * jt + lr;
          a0c[jt] = p.in[I_RW_A0][l * 256 + c]; kkc[jt] = p.in[I_RW_KK][l * 256 + c]; kac[jt] = p.in[I_RW_KA][l * 256 + c]; w00[jt] = w0[c]; w01[jt] = w0[256 + c];
          m0r[jt] = mu0[c]; m1r[jt] = mu1[c]; m0k[jt] = mu0[256 + c]; m1k[jt] = mu1[256 + c]; m0v[jt] = mu0[512 + c]; m1v[jt] = mu1[512 + c]; }
      __syncthreads();
      for (int tile = F.bid; tile < T / 16; tile += F.nblk) {
          const int r0 = tile * 16;
          { float cv[4], pv[4], nv[4];
#pragma unroll
            for (int k = 0; k < 4; ++k) { const int idx = F.tid + 512 * k, tt = idx >> 7, ci = 768 + (idx & 127), r = r0 + tt; int pos, len; seq_of(r, pos, len);
                const bf16_t* ur = U + (size_t)r * NINP + U_RW + ci; cv[k] = bf2f(ur[0]); pv[k] = pos > 0 ? bf2f(ur[-NINP]) : 0.f; nv[k] = pos < len - 1 ? bf2f(ur[NINP]) : 0.f; }
#pragma unroll
            for (int k = 0; k < 4; ++k) { const int idx = F.tid + 512 * k, tt = idx >> 7, cj = idx & 127, ci = 768 + cj; float val = cv[k] + mu0[ci] * (pv[k] - cv[k]) + mu1[ci] * (nv[k] - cv[k]); if (cj < 64) val = 1.0f - 2.0f * __builtin_amdgcn_rcpf(1.0f + __expf(2.0f * val));
                *(LAS bf16_t*)(inb + tt * 272 + cj * 2) = (bf16_t)(cvt_pk_bf16(val, 0.f) & 0xffffu); } }
          __syncthreads();
          f32x4 acc[3][2];
          { bf16x8 alw[2], ala[2];
#pragma unroll
            for (int s2 = 0; s2 < 2; ++s2) { alw[s2] = *(const LAS bf16x8*)(inb + lr * 272 + 64 * s2 + 16 * lq); ala[s2] = *(const LAS bf16x8*)(inb + lr * 272 + 128 + 64 * s2 + 16 * lq); }
#pragma unroll
            for (int q = 0; q < 3; ++q)
#pragma unroll
                for (int jt = 0; jt < 2; ++jt) { acc[q][jt] = (f32x4){0.f, 0.f, 0.f, 0.f};
#pragma unroll
                    for (int s2 = 0; s2 < 2; ++s2) { const bf16x8 bw = *(const LAS bf16x8*)(WT + q * 36864 + (32 * F.wave + 16 * jt + lr) * 144 + 64 * s2 + 16 * lq);
                        acc[q][jt] = __builtin_amdgcn_mfma_f32_16x16x32_bf16(q == 0 ? ala[s2] : alw[s2], bw, acc[q][jt], 0, 0, 0); } } }
          float rrv[2][4], krv[2][4], vvv[2][4], kkr[2][4], ssp[4];
#pragma unroll
          for (int i = 0; i < 4; ++i) ssp[i] = 0.f;
#pragma unroll
          for (int jt = 0; jt < 2; ++jt) { const int c = 32 * F.wave + 16 * jt + lr;
              float cr[4], pr[4], nr[4], ck[4], pk[4], nk[4], cvv[4], pvv[4], nvv[4];
#pragma unroll
              for (int i = 0; i < 4; ++i) { const int r = r0 + 4 * lq + i; int pos, len; seq_of(r, pos, len); const bf16_t* ur = U + (size_t)r * NINP + U_RW + c; const bool hp = pos > 0, hn = pos < len - 1;
                  cr[i] = bf2f(ur[0]); ck[i] = bf2f(ur[256]); cvv[i] = bf2f(ur[512]);
                  pr[i] = hp ? bf2f(ur[-NINP]) : 0.f; pk[i] = hp ? bf2f(ur[256 - NINP]) : 0.f; pvv[i] = hp ? bf2f(ur[512 - NINP]) : 0.f;
                  nr[i] = hn ? bf2f(ur[NINP]) : 0.f; nk[i] = hn ? bf2f(ur[256 + NINP]) : 0.f; nvv[i] = hn ? bf2f(ur[512 + NINP]) : 0.f; }
#pragma unroll
              for (int i = 0; i < 4; ++i) { rrv[jt][i] = cr[i] + m0r[jt] * (pr[i] - cr[i]) + m1r[jt] * (nr[i] - cr[i]); krv[jt][i] = ck[i] + m0k[jt] * (pk[i] - ck[i]) + m1k[jt] * (nk[i] - ck[i]); vvv[jt][i] = cvv[i] + m0v[jt] * (pvv[i] - cvv[i]) + m1v[jt] * (nvv[i] - cvv[i]);
                  kkr[jt][i] = krv[jt][i] * kkc[jt]; ssp[i] += kkr[jt][i] * kkr[jt][i]; } }
#pragma unroll
          for (int i = 0; i < 4; ++i) { ssp[i] = sum16(ssp[i]); if (lr == 0) red[(4 * lq + i) * 8 + F.wave] = ssp[i]; }
          __syncthreads();
#pragma unroll
          for (int i = 0; i < 4; ++i) { const int tt = 4 * lq + i, r = r0 + tt; const float ss = red[tt * 8 + F.wave] + red[tt * 8 + (F.wave ^ 1)]; const float rn = 1.0f / fmaxf(sqrtf(ss), 1e-12f);
#pragma unroll
              for (int jt = 0; jt < 2; ++jt) { const int c = 32 * F.wave + 16 * jt + lr;
                  const float a = 1.0f / (1.0f + __expf(-(a0c[jt] + acc[0][jt][i]))); const float kk = kkr[jt][i] * rn;
                  const float k2 = krv[jt][i] * (1.0f + (a - 1.0f) * kac[jt]);
                  const float wv0 = __expf(-0.6065306597126334f / (1.0f + __expf(-(w00[jt] + acc[1][jt][i])))), wv1 = __expf(-0.6065306597126334f / (1.0f + __expf(-(w01[jt] + acc[2][jt][i]))));
                  float* sp = S + ((size_t)r * 4 + hh) * 448 + (c & 63);
                  sp[0] = rrv[jt][i]; sp[64] = wv0; sp[128] = wv1; sp[192] = k2; sp[256] = -kk; sp[320] = kk * a; sp[384] = vvv[jt][i]; } }
          __syncthreads();
      }
      for (int idx = F.tid; idx < 64 * 256; idx += 512) { const int kp = idx >> 8, n = idx & 255; *(LAS unsigned*)(WT + n * 272 + kp * 4) = cvt_pk_bf16(wg[(2 * kp) * 256 + n], wg[(2 * kp + 1) * 256 + n]); }
      __syncthreads();
      for (int tile = F.bid; tile < T / 16; tile += F.nblk) {
          const int r0 = tile * 16;
          { float cv[4], pv[4], nv[4];
#pragma unroll
            for (int k = 0; k < 4; ++k) { const int idx = F.tid + 512 * k, tt = idx >> 7, ci = 896 + (idx & 127), r = r0 + tt; int pos, len; seq_of(r, pos, len);
                const bf16_t* ur = U + (size_t)r * NINP + U_RW + ci; cv[k] = bf2f(ur[0]); pv[k] = pos > 0 ? bf2f(ur[-NINP]) : 0.f; nv[k] = pos < len - 1 ? bf2f(ur[NINP]) : 0.f; }
#pragma unroll
            for (int k = 0; k < 4; ++k) { const int idx = F.tid + 512 * k, tt = idx >> 7, cj = idx & 127, ci = 896 + cj; const float val = sigmoid_fast(cv[k] + mu0[ci] * (pv[k] - cv[k]) + mu1[ci] * (nv[k] - cv[k]));
                *(LAS bf16_t*)(inb + tt * 272 + cj * 2) = (bf16_t)(cvt_pk_bf16(val, 0.f) & 0xffffu); } }
          __syncthreads();
          f32x4 ag[2];
          { bf16x8 alg[4];
#pragma unroll
            for (int s4 = 0; s4 < 4; ++s4) alg[s4] = *(const LAS bf16x8*)(inb + lr * 272 + 64 * s4 + 16 * lq);
#pragma unroll
            for (int jt = 0; jt < 2; ++jt) { ag[jt] = (f32x4){0.f, 0.f, 0.f, 0.f};
#pragma unroll
                for (int s4 = 0; s4 < 4; ++s4) { const bf16x8 bw = *(const LAS bf16x8*)(WT + (32 * F.wave + 16 * jt + lr) * 272 + 64 * s4 + 16 * lq); ag[jt] = __builtin_amdgcn_mfma_f32_16x16x32_bf16(alg[s4], bw, ag[jt], 0, 0, 0); } } }
#pragma unroll
          for (int jt = 0; jt < 2; ++jt)
#pragma unroll
              for (int i = 0; i < 4; ++i) G[(size_t)(r0 + 4 * lq + i) * 256 + 32 * F.wave + 16 * jt + lr] = ag[jt][i];
          __syncthreads();
      }
      }
    }
}
__device__ __forceinline__ int seg_r0(int b, int dir, int pp) { return pp < 4 ? TL + b * CTXL + (dir ? 3 - pp : pp) * 64 : b * SEQ + (dir ? 63 - (pp - 4) : pp - 4) * 64; }
typedef float f32x2v __attribute__((ext_vector_type(2)));
#define MEMFENCE() asm volatile("" ::: "memory")

__device__ __forceinline__ void rwkv_pass1(const Params& p, const Frame& F, int ci, int pp, LAS float* wl) {
    int lane = F.lane; asm volatile("" : "+v"(lane));
    const int b = ci >> 3, h = (ci >> 1) & 3, dir = ci & 1, r0 = seg_r0(b, dir, pp);
    const float* S = (const float*)(p.ws + WS_RW);
    float* Y = (float*)(p.ws + (dir ? WS_Y2 : WS_Y)) + (size_t)2 * T * 256; float* Z = (float*)(p.ws + WS_ZRW) + (size_t)dir * T * 256;
    f32x2v sE[32], sP[32];
#pragma unroll
    for (int j = 0; j < 32; ++j) { sE[j] = (f32x2v){0.f, 0.f}; sP[j] = (f32x2v){(2 * j == lane) ? 1.f : 0.f, (2 * j + 1 == lane) ? 1.f : 0.f}; }
    float pre[4][7];
#pragma unroll
    for (int s4 = 0; s4 < 4; ++s4) { const int row = r0 + (dir ? 63 - s4 : s4); const float* base = S + ((size_t)row * 4 + h) * 448 + lane;
#pragma unroll
        for (int q = 0; q < 7; ++q) pre[s4][q] = base[q * 64]; }
    for (int n0 = 0; n0 < 64; n0 += 4) {
        MEMFENCE();
#pragma unroll
        for (int s4 = 0; s4 < 4; ++s4)
#pragma unroll
            for (int q = 0; q < 7; ++q) wl[s4 * 448 + q * 64 + lane] = pre[s4][q];
        MEMFENCE();
        if (n0 + 4 < 64) {
#pragma unroll
            for (int s4 = 0; s4 < 4; ++s4) { const int row = r0 + (dir ? 63 - (n0 + 4 + s4) : n0 + 4 + s4); const float* base = S + ((size_t)row * 4 + h) * 448 + lane;
#pragma unroll
                for (int q = 0; q < 7; ++q) pre[s4][q] = base[q * 64]; }
        }
#pragma unroll 1
        for (int s4 = 0; s4 < 4; ++s4) {
            const LAS float* o = wl + s4 * 448; const LAS float* pw = o + 64 * (1 + dir);
            const int row = r0 + (dir ? 63 - (n0 + s4) : n0 + s4);
            const float v = o[384 + lane];
            f32x2v aE0 = {0.f, 0.f}, aE1 = {0.f, 0.f}, aP0 = {0.f, 0.f}, aP1 = {0.f, 0.f};
            f32x4 av[16], wv[16], bv[16], kv[16], rv[16];
#pragma unroll
            for (int q = 0; q < 4; ++q) av[q] = *(const LAS f32x4*)(o + 256 + 4 * q);
#pragma unroll
            for (int jj = 0; jj < 16; ++jj) {
                if (jj + 4 < 16) av[jj + 4] = *(const LAS f32x4*)(o + 256 + 4 * (jj + 4));
                else if (jj + 4 < 18) { const int q = jj + 4 - 16; wv[q] = *(const LAS f32x4*)(pw + 4 * q); bv[q] = *(const LAS f32x4*)(o + 320 + 4 * q); kv[q] = *(const LAS f32x4*)(o + 192 + 4 * q); rv[q] = *(const LAS f32x4*)(o + 4 * q); }
                MEMFENCE();
                const f32x2v alo = {av[jj].x, av[jj].y}, ahi = {av[jj].z, av[jj].w};
                aE0 += sE[2 * jj] * alo; aE1 += sE[2 * jj + 1] * ahi; aP0 += sP[2 * jj] * alo; aP1 += sP[2 * jj + 1] * ahi; }
            const float saE = (aE0.x + aE0.y) + (aE1.x + aE1.y), saP = (aP0.x + aP0.y) + (aP1.x + aP1.y);
            const f32x2v saE2 = {saE, saE}, saP2 = {saP, saP}, v2 = {v, v};
            f32x2v yE0 = {0.f, 0.f}, yE1 = {0.f, 0.f}, zP0 = {0.f, 0.f}, zP1 = {0.f, 0.f};
#pragma unroll
            for (int jj = 0; jj < 16; ++jj) {
                if (jj + 2 < 16) { const int q = jj + 2; wv[q] = *(const LAS f32x4*)(pw + 4 * q); bv[q] = *(const LAS f32x4*)(o + 320 + 4 * q); kv[q] = *(const LAS f32x4*)(o + 192 + 4 * q); rv[q] = *(const LAS f32x4*)(o + 4 * q); }
                MEMFENCE();
                const f32x4 w4 = wv[jj], b4 = bv[jj], k4 = kv[jj], r4 = rv[jj];
                const f32x2v wlo = {w4.x, w4.y}, whi = {w4.z, w4.w}, blo = {b4.x, b4.y}, bhi = {b4.z, b4.w}, klo = {k4.x, k4.y}, khi = {k4.z, k4.w}, rlo = {r4.x, r4.y}, rhi = {r4.z, r4.w};
                sE[2 * jj] = sE[2 * jj] * wlo + saE2 * blo + v2 * klo; sE[2 * jj + 1] = sE[2 * jj + 1] * whi + saE2 * bhi + v2 * khi;
                sP[2 * jj] = sP[2 * jj] * wlo + saP2 * blo; sP[2 * jj + 1] = sP[2 * jj + 1] * whi + saP2 * bhi;
                yE0 += sE[2 * jj] * rlo; yE1 += sE[2 * jj + 1] * rhi; zP0 += sP[2 * jj] * rlo; zP1 += sP[2 * jj + 1] * rhi; }
            Y[(size_t)row * 256 + h * 64 + lane] = (yE0.x + yE0.y) + (yE1.x + yE1.y);
            Z[(size_t)row * 256 + h * 64 + lane] = (zP0.x + zP0.y) + (zP1.x + zP1.y);
        }
    }
    float* E = (float*)(p.ws + WS_RWE) + ((size_t)(ci * NSEG + pp) * 64 + lane) * 64; float* P = (float*)(p.ws + WS_RWP) + ((size_t)(ci * NSEG + pp) * 64 + lane) * 64;
#pragma unroll
    for (int jj = 0; jj < 16; ++jj) { *(f32x4*)(E + 4 * jj) = (f32x4){sE[2 * jj].x, sE[2 * jj].y, sE[2 * jj + 1].x, sE[2 * jj + 1].y}; *(f32x4*)(P + 4 * jj) = (f32x4){sP[2 * jj].x, sP[2 * jj].y, sP[2 * jj + 1].x, sP[2 * jj + 1].y}; }
}
__device__ __forceinline__ void ssd_pass1(const Params& p, const Frame& F, int ci, int pp, LAS float* wl) {
    int lane = F.lane; asm volatile("" : "+v"(lane));
    const int b = ci >> 3, h = (ci >> 1) & 3, dir = ci & 1, r0 = seg_r0(b, dir, pp), g = h >> 1;
    const float* XBC = (const float*)(p.ws + WS_XBC); const float* DT = (const float*)(p.ws + WS_DT);
    float* Y = (float*)(p.ws + (dir ? WS_Y2 : WS_Y)) + (size_t)T * 256; float* Z = (float*)(p.ws + WS_ZSS) + (size_t)dir * T * 256;
    LAS unsigned char* wb = (LAS unsigned char*)wl;
    f32x2v hs[32];
#pragma unroll
    for (int j = 0; j < 32; ++j) hs[j] = (f32x2v){0.f, 0.f};
    float cum = 1.f;
    float pre[8][4];
#pragma unroll
    for (int s8 = 0; s8 < 8; ++s8) { const int row = r0 + (dir ? 63 - s8 : s8); const float* xb = XBC + (size_t)row * 512;
        pre[s8][0] = xb[256 + g * 64 + lane]; pre[s8][1] = xb[384 + g * 64 + lane]; pre[s8][2] = xb[h * 64 + lane]; pre[s8][3] = DT[(size_t)row * 16 + dir * 4 + h + ((lane & 1) ? 8 : 0)]; }
    for (int n0 = 0; n0 < 64; n0 += 8) {
        MEMFENCE();
#pragma unroll
        for (int s8 = 0; s8 < 8; ++s8) { LAS unsigned char* o = wb + s8 * 528;
            *(LAS bf16_t*)(o + lane * 2) = (bf16_t)(cvt_pk_bf16(pre[s8][0], 0.f) & 0xffffu); *(LAS bf16_t*)(o + 128 + lane * 2) = (bf16_t)(cvt_pk_bf16(pre[s8][1], 0.f) & 0xffffu);
            *(LAS float*)(o + 256 + lane * 4) = pre[s8][2]; if (lane < 2) *(LAS float*)(o + 512 + lane * 4) = pre[s8][3]; }
        MEMFENCE();
        if (n0 + 8 < 64) {
#pragma unroll
            for (int s8 = 0; s8 < 8; ++s8) { const int row = r0 + (dir ? 63 - (n0 + 8 + s8) : n0 + 8 + s8); const float* xb = XBC + (size_t)row * 512;
                pre[s8][0] = xb[256 + g * 64 + lane]; pre[s8][1] = xb[384 + g * 64 + lane]; pre[s8][2] = xb[h * 64 + lane]; pre[s8][3] = DT[(size_t)row * 16 + dir * 4 + h + ((lane & 1) ? 8 : 0)]; }
        }
#pragma unroll 1
        for (int s8 = 0; s8 < 8; ++s8) {
            const LAS unsigned char* o = wb + s8 * 528; const int row = r0 + (dir ? 63 - (n0 + s8) : n0 + s8);
            const float dt = *(const LAS float*)(o + 512), dA = *(const LAS float*)(o + 516), xdt = *(const LAS float*)(o + 256 + lane * 4) * dt, cl = bf2f(*(const LAS bf16_t*)(o + 128 + lane * 2));
            const f32x2v dA2 = {dA, dA}, x2 = {xdt, xdt};
            f32x2v y0 = {0.f, 0.f}, y1 = {0.f, 0.f};
            u32x4 bq[8], cq[8];
#pragma unroll
            for (int q = 0; q < 3; ++q) { bq[q] = *(const LAS u32x4*)(o + 16 * q); cq[q] = *(const LAS u32x4*)(o + 128 + 16 * q); }
#pragma unroll
            for (int j8 = 0; j8 < 8; ++j8) {
                if (j8 + 3 < 8) { bq[j8 + 3] = *(const LAS u32x4*)(o + 16 * (j8 + 3)); cq[j8 + 3] = *(const LAS u32x4*)(o + 128 + 16 * (j8 + 3)); }
                MEMFENCE();
#pragma unroll
                for (int e = 0; e < 4; ++e) { const unsigned ub = bq[j8][e], uc = cq[j8][e];
                    const f32x2v bv = {__uint_as_float(ub << 16), __uint_as_float(ub & 0xffff0000u)}, cv = {__uint_as_float(uc << 16), __uint_as_float(uc & 0xffff0000u)};
                    hs[4 * j8 + e] = hs[4 * j8 + e] * dA2 + x2 * bv; if (e & 1) y1 += hs[4 * j8 + e] * cv; else y0 += hs[4 * j8 + e] * cv; } }
            cum *= dA;
            Y[(size_t)row * 256 + h * 64 + lane] = (y0.x + y0.y) + (y1.x + y1.y);
            Z[(size_t)row * 256 + h * 64 + lane] = cl * cum;
        }
    }
    float* E = (float*)(p.ws + WS_SSE) + ((size_t)(ci * NSEG + pp) * 64 + lane) * 64;
#pragma unroll
    for (int jj = 0; jj < 16; ++jj) *(f32x4*)(E + 4 * jj) = (f32x4){hs[2 * jj].x, hs[2 * jj].y, hs[2 * jj + 1].x, hs[2 * jj + 1].y};
    if (lane == 0) ((float*)(p.ws + WS_SDEC))[ci * NSEG + pp] = cum;
}
__device__ __forceinline__ void gla_pass1(const Params& p, const Frame& F, int ci, int pp, LAS float* wl) {
    int lane = F.lane; asm volatile("" : "+v"(lane));
    const int b = ci >> 3, h = (ci >> 1) & 3, dir = ci & 1, r0 = seg_r0(b, dir, pp);
    const bf16_t* U = (const bf16_t*)(p.ws + WS_U); const float* DEC = (const float*)(p.ws + WS_DEC);
    float* Y = (float*)(p.ws + (dir ? WS_Y2 : WS_Y)); float* Z = (float*)(p.ws + WS_ZGL) + (size_t)dir * T * 128;
    LAS unsigned char* wb = (LAS unsigned char*)wl;
    const float scale = 0.17677669529663687f;
    f32x2v st[16];
#pragma unroll
    for (int j = 0; j < 16; ++j) st[j] = (f32x2v){0.f, 0.f};
    float Wl = 1.f;
    const int qkcol = lane < 32 ? U_GLA_Q + h * 32 + lane : U_GLA_K + h * 32 + (lane - 32);
    bf16_t preq[8]; float prea[8]; bf16_t prev_[8];
#pragma unroll
    for (int s8 = 0; s8 < 8; ++s8) { const int row = r0 + (dir ? 63 - s8 : s8); const bf16_t* ur = U + (size_t)row * NINP;
        preq[s8] = ur[qkcol]; prea[s8] = DEC[(size_t)row * 256 + dir * 128 + h * 32 + (lane & 31)]; prev_[s8] = ur[U_GLA_V + h * 64 + lane]; }
    for (int n0 = 0; n0 < 64; n0 += 8) {
        MEMFENCE();
#pragma unroll
        for (int s8 = 0; s8 < 8; ++s8) { LAS unsigned char* o = wb + s8 * 512; *(LAS bf16_t*)(o + lane * 2) = preq[s8]; if (lane < 32) *(LAS float*)(o + 128 + lane * 4) = prea[s8]; *(LAS float*)(o + 256 + lane * 4) = bf2f(prev_[s8]); }
        MEMFENCE();
        if (n0 + 8 < 64) {
#pragma unroll
            for (int s8 = 0; s8 < 8; ++s8) { const int row = r0 + (dir ? 63 - (n0 + 8 + s8) : n0 + 8 + s8); const bf16_t* ur = U + (size_t)row * NINP;
                preq[s8] = ur[qkcol]; prea[s8] = DEC[(size_t)row * 256 + dir * 128 + h * 32 + (lane & 31)]; prev_[s8] = ur[U_GLA_V + h * 64 + lane]; }
        }
#pragma unroll 1
        for (int s8 = 0; s8 < 8; ++s8) {
            const LAS unsigned char* o = wb + s8 * 512; const int row = r0 + (dir ? 63 - (n0 + s8) : n0 + s8);
            const float v = *(const LAS float*)(o + 256 + lane * 4), al = *(const LAS float*)(o + 128 + (lane & 31) * 4), ql = bf2f(*(const LAS bf16_t*)(o + (lane & 31) * 2));
            const f32x2v v2 = {v, v};
            f32x2v y0 = {0.f, 0.f}, y1 = {0.f, 0.f};
            u32x4 qq[4], kq[4]; f32x4 aq[8];
#pragma unroll
            for (int q = 0; q < 4; ++q) { qq[q] = *(const LAS u32x4*)(o + 16 * q); kq[q] = *(const LAS u32x4*)(o + 64 + 16 * q); aq[2 * q] = *(const LAS f32x4*)(o + 128 + 32 * q); aq[2 * q + 1] = *(const LAS f32x4*)(o + 128 + 32 * q + 16); }
            MEMFENCE();
#pragma unroll
            for (int j4 = 0; j4 < 4; ++j4)
#pragma unroll
                for (int e = 0; e < 4; ++e) { const unsigned uq = qq[j4][e], uk = kq[j4][e]; const f32x4 a4 = aq[2 * j4 + (e >> 1)];
                    const f32x2v qv = {__uint_as_float(uq << 16), __uint_as_float(uq & 0xffff0000u)}, kv = {__uint_as_float(uk << 16), __uint_as_float(uk & 0xffff0000u)};
                    const f32x2v av = (e & 1) ? (f32x2v){a4.z, a4.w} : (f32x2v){a4.x, a4.y};
                    st[4 * j4 + e] = st[4 * j4 + e] * av + v2 * kv; if (e & 1) y1 += st[4 * j4 + e] * qv; else y0 += st[4 * j4 + e] * qv; }
            Wl *= al;
            Y[(size_t)row * 256 + h * 64 + lane] = ((y0.x + y0.y) + (y1.x + y1.y)) * scale;
            if (lane < 32) Z[(size_t)row * 128 + h * 32 + lane] = scale * ql * Wl;
        }
    }
    float* E = (float*)(p.ws + WS_GLE) + (size_t)(ci * NSEG + pp) * 2048 + lane;
#pragma unroll
    for (int j = 0; j < 16; ++j) { E[(2 * j) * 64] = st[j].x; E[(2 * j + 1) * 64] = st[j].y; }
    if (lane < 32) ((float*)(p.ws + WS_GDEC))[(ci * NSEG + pp) * 32 + lane] = Wl;
}
__device__ __forceinline__ void phase_s1(const Params& p, const Frame& F, int mlo = 0, int mhi = 3) {
    LAS float* wl = (LAS float*)(F.lds + F.wave * 8192);
    constexpr int NI = NCHAIN * NSEG;
    const int lo = (int)(((long)F.bid * NI) / F.nblk), hi = (int)(((long)(F.bid + 1) * NI) / F.nblk), n = hi - lo;
    for (int q = (mlo * n) + F.wave; q < mhi * n; q += 8) {
        const int mixer = q / n, r = lo + (q - mixer * n), ci = r & 31, pp = r >> 5;
        if (mixer == 0) rwkv_pass1(p, F, ci, pp, wl); else if (mixer == 1) ssd_pass1(p, F, ci, pp, wl); else gla_pass1(p, F, ci, pp, wl);
    }
}
__device__ __forceinline__ void rwkv_combine(const Params& p, const Frame& F, int ci) {
    LAS float* Sb = (LAS float*)F.lds;
    LAS float* Pb = Sb + 2 * 64 * 66;
    float* E = (float*)(p.ws + WS_RWE) + (size_t)ci * NSEG * 4096; const float* P = (const float*)(p.ws + WS_RWP) + (size_t)ci * NSEG * 4096;
    const int ti = F.wave & 3, tj0 = (F.wave >> 2) * 2, lr = F.lane & 15, lq = F.lane >> 4;
    const int prow = F.tid >> 3, pcol = (F.tid & 7) * 8;
    for (int idx = F.tid; idx < 64 * 66; idx += 512) Sb[idx] = 0.f;
    { const f32x4 a = *(const f32x4*)(P + prow * 64 + pcol), b = *(const f32x4*)(P + prow * 64 + pcol + 4);
      *(LAS f32x4*)(Pb + prow * 80 + pcol) = a; *(LAS f32x4*)(Pb + prow * 80 + pcol + 4) = b; }
    __syncthreads();
    f32x4 sreg[2] = {(f32x4){0.f, 0.f, 0.f, 0.f}, (f32x4){0.f, 0.f, 0.f, 0.f}};
    f32x4 enext[2];
#pragma unroll
    for (int t2 = 0; t2 < 2; ++t2)
#pragma unroll
        for (int e = 0; e < 4; ++e) enext[t2][e] = E[(16 * ti + 4 * lq + e) * 64 + 16 * (tj0 + t2) + lr];
    for (int pp = 0; pp < NSEG; ++pp) {
        const int cur = pp & 1; float* Ep = E + (size_t)pp * 4096;
        f32x4 acc[2] = {enext[0], enext[1]};
#pragma unroll
        for (int t2 = 0; t2 < 2; ++t2)
#pragma unroll
            for (int e = 0; e < 4; ++e) { Ep[(16 * ti + 4 * lq + e) * 64 + 16 * (tj0 + t2) + lr] = sreg[t2][e]; if (pp + 1 < NSEG) enext[t2][e] = Ep[4096 + (16 * ti + 4 * lq + e) * 64 + 16 * (tj0 + t2) + lr]; }
        if (pp == NSEG - 1) break;
        f32x4 pa, pb; const bool more = pp + 1 < NSEG - 1;
        if (more) { pa = *(const f32x4*)(P + (size_t)(pp + 1) * 4096 + prow * 64 + pcol); pb = *(const f32x4*)(P + (size_t)(pp + 1) * 4096 + prow * 64 + pcol + 4); }
        const LAS float* Sc = Sb + cur * 64 * 66; const LAS float* Pc = Pb + cur * 64 * 80;
#pragma unroll
        for (int kk = 0; kk < 16; ++kk) { const float a = Sc[(16 * ti + lr) * 66 + 4 * kk + lq], b0 = Pc[(4 * kk + lq) * 80 + 16 * tj0 + lr], b1 = Pc[(4 * kk + lq) * 80 + 16 * tj0 + 16 + lr];
            acc[0] = __builtin_amdgcn_mfma_f32_16x16x4f32(a, b0, acc[0], 0, 0, 0); acc[1] = __builtin_amdgcn_mfma_f32_16x16x4f32(a, b1, acc[1], 0, 0, 0); }
        sreg[0] = acc[0]; sreg[1] = acc[1];
        LAS float* Sn = Sb + (cur ^ 1) * 64 * 66;
#pragma unroll
        for (int t2 = 0; t2 < 2; ++t2)
#pragma unroll
            for (int e = 0; e < 4; ++e) Sn[(16 * ti + 4 * lq + e) * 66 + 16 * (tj0 + t2) + lr] = acc[t2][e];
        if (more) { LAS float* Pn = Pb + (cur ^ 1) * 64 * 80; *(LAS f32x4*)(Pn + prow * 80 + pcol) = pa; *(LAS f32x4*)(Pn + prow * 80 + pcol + 4) = pb; }
        __syncthreads();
    }
    __syncthreads();
}
__device__ __forceinline__ void ew_combine(const Params& p, int item) {
    if (item < NCHAIN * 1024) { const int ci = item >> 10, idx = (item & 1023) * 4;
        float* E = (float*)(p.ws + WS_SSE) + (size_t)ci * NSEG * 4096 + idx; const float* dec = (const float*)(p.ws + WS_SDEC) + ci * NSEG;
        f32x4 S = {0.f, 0.f, 0.f, 0.f};
#pragma unroll 4
        for (int pp = 0; pp < NSEG; ++pp) { f32x4* q = (f32x4*)(E + (size_t)pp * 4096); const f32x4 t = *q; *q = S; S = S * dec[pp] + t; }
    } else { const int it2 = item - NCHAIN * 1024, ci = it2 >> 9, idx = (it2 & 511) * 4, d = idx >> 6;
        float* E = (float*)(p.ws + WS_GLE) + (size_t)ci * NSEG * 2048 + idx; const float* dec = (const float*)(p.ws + WS_GDEC) + (size_t)ci * NSEG * 32 + d;
        f32x4 S = {0.f, 0.f, 0.f, 0.f};
#pragma unroll 4
        for (int pp = 0; pp < NSEG; ++pp) { f32x4* q = (f32x4*)(E + (size_t)pp * 2048); const f32x4 t = *q; *q = S; S = S * dec[pp * 32] + t; }
    }
}
__device__ __forceinline__ void att_item(const Params& p, const Frame& F, int item, float mshift) {
    const bool isctx = item >= 512; int b, hkv, qb;
    if (!isctx) { b = item >> 7; hkv = (item >> 6) & 1; qb = item & 63; } else { const int i2 = item - 512; b = i2 >> 3; hkv = (i2 >> 2) & 1; qb = i2 & 3; }
    const int kt0 = isctx ? 64 : 0, kt1 = 68;
    const bf16_t* Kg = (const bf16_t*)(p.ws + WS_ATTK) + (size_t)(b * 2 + hkv) * NKEY * 64;
    const bf16_t* Vg = (const bf16_t*)(p.ws + WS_ATTVT) + (size_t)(b * 2 + hkv) * 64 * NKEY;
    const bf16_t* Qg = (const bf16_t*)(p.ws + WS_ATTQ); bf16_t* atto = (bf16_t*)(p.ws + WS_ATTO);
    const int hq = hkv * 2 + (F.wave >> 2), q0 = qb * 64 + (F.wave & 3) * 16, c = F.lane & 15, g = F.lane >> 4;
    const int qtok = isctx ? (TL + b * CTXL + q0 + c) : (b * SEQ + q0 + c);
    bf16x8 qf[2];
#pragma unroll
    for (int dc = 0; dc < 2; ++dc) qf[dc] = *(const bf16x8*)(Qg + (size_t)qtok * 256 + hq * 64 + 32 * dc + 8 * g);
    const int srow = F.tid >> 3, sch = F.tid & 7;
    u32x4 kreg = *(const u32x4*)(Kg + (size_t)(kt0 * 64 + srow) * 64 + sch * 8), vreg = *(const u32x4*)(Vg + (size_t)srow * NKEY + kt0 * 64 + sch * 8);
    *(LAS u32x4*)(F.lds + srow * 144 + sch * 16) = kreg; *(LAS u32x4*)(F.lds + 9216 + srow * 144 + sch * 16) = vreg;
    __syncthreads();
    f32x4 O[4]; float lsum = 0.f;
#pragma unroll
    for (int dt = 0; dt < 4; ++dt) O[dt] = (f32x4){0.f, 0.f, 0.f, 0.f};
    for (int kt = kt0; kt < kt1; ++kt) {
        const int cur = (kt - kt0) & 1; const bool more = kt + 1 < kt1;
        if (more) { kreg = *(const u32x4*)(Kg + (size_t)((kt + 1) * 64 + srow) * 64 + sch * 8); vreg = *(const u32x4*)(Vg + (size_t)srow * NKEY + (kt + 1) * 64 + sch * 8); }
        const LAS unsigned char* Ks = F.lds + cur * 18432; const LAS unsigned char* Vs = Ks + 9216;
        f32x4 st[4];
#pragma unroll
        for (int ks = 0; ks < 4; ++ks) { st[ks] = (f32x4){-mshift, -mshift, -mshift, -mshift};
#pragma unroll
            for (int dc = 0; dc < 2; ++dc) { const bf16x8 kf = *(const LAS bf16x8*)(Ks + (16 * ks + c) * 144 + (32 * dc + 8 * g) * 2); st[ks] = __builtin_amdgcn_mfma_f32_16x16x32_bf16(kf, qf[dc], st[ks], 0, 0, 0); } }
        float ps = 0.f;
#pragma unroll
        for (int ks = 0; ks < 4; ++ks)
#pragma unroll
            for (int i = 0; i < 4; ++i) { st[ks][i] = __builtin_amdgcn_exp2f(st[ks][i]); ps += st[ks][i]; }
        lsum += ps;
#pragma unroll
        for (int kc = 0; kc < 2; ++kc) {
            u32x4 pw; pw.x = cvt_pk_bf16(st[2 * kc][0], st[2 * kc][1]); pw.y = cvt_pk_bf16(st[2 * kc][2], st[2 * kc][3]); pw.z = cvt_pk_bf16(st[2 * kc + 1][0], st[2 * kc + 1][1]); pw.w = cvt_pk_bf16(st[2 * kc + 1][2], st[2 * kc + 1][3]);
            const bf16x8 pf = __builtin_bit_cast(bf16x8, pw);
#pragma unroll
            for (int dt = 0; dt < 4; ++dt) {
                const u32x2 v0 = *(const LAS u32x2*)(Vs + (16 * dt + c) * 144 + (32 * kc + 4 * g) * 2), v1 = *(const LAS u32x2*)(Vs + (16 * dt + c) * 144 + (32 * kc + 16 + 4 * g) * 2);
                u32x4 vw; vw.x = v0.x; vw.y = v0.y; vw.z = v1.x; vw.w = v1.y;
                O[dt] = __builtin_amdgcn_mfma_f32_16x16x32_bf16(__builtin_bit_cast(bf16x8, vw), pf, O[dt], 0, 0, 0);
            }
        }
        if (more) { *(LAS u32x4*)(F.lds + (cur ^ 1) * 18432 + srow * 144 + sch * 16) = kreg; *(LAS u32x4*)(F.lds + (cur ^ 1) * 18432 + 9216 + srow * 144 + sch * 16) = vreg; }
        __syncthreads();
    }
    lsum += __shfl_xor(lsum, 16); lsum += __shfl_xor(lsum, 32);
    const float il = 1.0f / lsum;
#pragma unroll
    for (int dt = 0; dt < 4; ++dt) { u32x2 w; w.x = cvt_pk_bf16(O[dt][0] * il, O[dt][1] * il); w.y = cvt_pk_bf16(O[dt][2] * il, O[dt][3] * il);
        *(u32x2*)(atto + (size_t)qtok * 256 + hq * 64 + 16 * dt + 4 * g) = w; }
}
__device__ __forceinline__ void pass3_item(const Params& p, const Frame& F, int it) {
    const int mixer = it / 1088, r = it % 1088, bh = r & 15, tb = r >> 4, b = bh >> 2, h = bh & 3;
    const int r0 = tb < 4 ? TL + b * CTXL + tb * 64 : b * SEQ + (tb - 4) * 64;
    const int ppf = tb, ppb = tb < 4 ? 3 - tb : 71 - tb, cif = bh * 2, cib = cif + 1;
    LAS float* Zf = (LAS float*)F.lds;
    LAS float* Sf = Zf + 64 * 66;
    LAS float* Zb = Sf + 64 * 66; LAS float* Sb = Zb + 64 * 66;
    const int t = F.tid >> 3;
    if (mixer < 2) {
        const float* Z0 = (const float*)(p.ws + (mixer == 0 ? WS_ZRW : WS_ZSS)); const float* Z1 = Z0 + (size_t)T * 256;
        const float* E0 = (const float*)(p.ws + (mixer == 0 ? WS_RWE : WS_SSE));
        const float* SSf = E0 + (size_t)(cif * NSEG + ppf) * 4096; const float* SSb = E0 + (size_t)(cib * NSEG + ppb) * 4096;
        const int c0 = (F.tid & 7) * 8; const size_t zo = (size_t)(r0 + t) * 256 + h * 64 + c0;
        const f32x4 a0 = *(const f32x4*)(Z0 + zo), a1 = *(const f32x4*)(Z0 + zo + 4), b0 = *(const f32x4*)(Z1 + zo), b1 = *(const f32x4*)(Z1 + zo + 4);
        const f32x4 s0 = *(const f32x4*)(SSf + t * 64 + c0), s1 = *(const f32x4*)(SSf + t * 64 + c0 + 4), u0 = *(const f32x4*)(SSb + t * 64 + c0), u1 = *(const f32x4*)(SSb + t * 64 + c0 + 4);
        LAS f32x2v* q;
        q = (LAS f32x2v*)(Zf + t * 66 + c0); q[0] = (f32x2v){a0.x, a0.y}; q[1] = (f32x2v){a0.z, a0.w}; q[2] = (f32x2v){a1.x, a1.y}; q[3] = (f32x2v){a1.z, a1.w};
        q = (LAS f32x2v*)(Zb + t * 66 + c0); q[0] = (f32x2v){b0.x, b0.y}; q[1] = (f32x2v){b0.z, b0.w}; q[2] = (f32x2v){b1.x, b1.y}; q[3] = (f32x2v){b1.z, b1.w};
        q = (LAS f32x2v*)(Sf + t * 66 + c0); q[0] = (f32x2v){s0.x, s0.y}; q[1] = (f32x2v){s0.z, s0.w}; q[2] = (f32x2v){s1.x, s1.y}; q[3] = (f32x2v){s1.z, s1.w};
        q = (LAS f32x2v*)(Sb + t * 66 + c0); q[0] = (f32x2v){u0.x, u0.y}; q[1] = (f32x2v){u0.z, u0.w}; q[2] = (f32x2v){u1.x, u1.y}; q[3] = (f32x2v){u1.z, u1.w};
    } else {
        const float* Z0 = (const float*)(p.ws + WS_ZGL); const float* Z1 = Z0 + (size_t)T * 128;
        const float* E0 = (const float*)(p.ws + WS_GLE);
        const float* SSf = E0 + (size_t)(cif * NSEG + ppf) * 2048; const float* SSb = E0 + (size_t)(cib * NSEG + ppb) * 2048;
        const int c0 = (F.tid & 7) * 4; const size_t zo = (size_t)(r0 + t) * 128 + h * 32 + c0;
        const f32x4 a0 = *(const f32x4*)(Z0 + zo), b0 = *(const f32x4*)(Z1 + zo);
        const int idx = F.tid * 4, d = idx >> 6, v0 = idx & 63;
        const f32x4 s0 = *(const f32x4*)(SSf + idx), u0 = *(const f32x4*)(SSb + idx);
        LAS f32x2v* q;
        q = (LAS f32x2v*)(Zf + t * 66 + c0); q[0] = (f32x2v){a0.x, a0.y}; q[1] = (f32x2v){a0.z, a0.w};
        q = (LAS f32x2v*)(Zb + t * 66 + c0); q[0] = (f32x2v){b0.x, b0.y}; q[1] = (f32x2v){b0.z, b0.w};
        *(LAS f32x4*)(Sf + d * 80 + v0) = s0; *(LAS f32x4*)(Sb + d * 80 + v0) = u0;
    }
    const int ti = F.wave & 3, tj0 = (F.wave >> 2) * 2, lr = F.lane & 15, lq = F.lane >> 4;
    float* Y0 = (float*)(p.ws + WS_Y) + (size_t)(mixer == 0 ? 2 : (mixer == 1 ? 1 : 0)) * T * 256; const float* Y1 = (const float*)(p.ws + WS_Y2) + (size_t)(mixer == 0 ? 2 : (mixer == 1 ? 1 : 0)) * T * 256;
    f32x4 acc[2];
#pragma unroll
    for (int t2 = 0; t2 < 2; ++t2)
#pragma unroll
        for (int e = 0; e < 4; ++e) { const size_t o = (size_t)(r0 + 16 * ti + 4 * lq + e) * 256 + h * 64 + 16 * (tj0 + t2) + lr; acc[t2][e] = Y0[o] + Y1[o]; }
    __syncthreads();
    if (mixer < 2) {
#pragma unroll
        for (int kk = 0; kk < 16; ++kk) { const float a = Zf[(16 * ti + lr) * 66 + 4 * kk + lq], b0 = Sf[(16 * tj0 + lr) * 66 + 4 * kk + lq], b1 = Sf[(16 * tj0 + 16 + lr) * 66 + 4 * kk + lq];
            acc[0] = __builtin_amdgcn_mfma_f32_16x16x4f32(a, b0, acc[0], 0, 0, 0); acc[1] = __builtin_amdgcn_mfma_f32_16x16x4f32(a, b1, acc[1], 0, 0, 0); }
#pragma unroll
        for (int kk = 0; kk < 16; ++kk) { const float a = Zb[(16 * ti + lr) * 66 + 4 * kk + lq], b0 = Sb[(16 * tj0 + lr) * 66 + 4 * kk + lq], b1 = Sb[(16 * tj0 + 16 + lr) * 66 + 4 * kk + lq];
            acc[0] = __builtin_amdgcn_mfma_f32_16x16x4f32(a, b0, acc[0], 0, 0, 0); acc[1] = __builtin_amdgcn_mfma_f32_16x16x4f32(a, b1, acc[1], 0, 0, 0); }
    } else {
#pragma unroll
        for (int kk = 0; kk < 8; ++kk) { const float a = Zf[(16 * ti + lr) * 66 + 4 * kk + lq], b0 = Sf[(4 * kk + lq) * 80 + 16 * tj0 + lr], b1 = Sf[(4 * kk + lq) * 80 + 16 * tj0 + 16 + lr];
            acc[0] = __builtin_amdgcn_mfma_f32_16x16x4f32(a, b0, acc[0], 0, 0, 0); acc[1] = __builtin_amdgcn_mfma_f32_16x16x4f32(a, b1, acc[1], 0, 0, 0); }
#pragma unroll
        for (int kk = 0; kk < 8; ++kk) { const float a = Zb[(16 * ti + lr) * 66 + 4 * kk + lq], b0 = Sb[(4 * kk + lq) * 80 + 16 * tj0 + lr], b1 = Sb[(4 * kk + lq) * 80 + 16 * tj0 + 16 + lr];
            acc[0] = __builtin_amdgcn_mfma_f32_16x16x4f32(a, b0, acc[0], 0, 0, 0); acc[1] = __builtin_amdgcn_mfma_f32_16x16x4f32(a, b1, acc[1], 0, 0, 0); }
    }
#pragma unroll
    for (int t2 = 0; t2 < 2; ++t2)
#pragma unroll
        for (int e = 0; e < 4; ++e) Y0[(size_t)(r0 + 16 * ti + 4 * lq + e) * 256 + h * 64 + 16 * (tj0 + t2) + lr] = acc[t2][e];
    __syncthreads();
}
__device__ __forceinline__ void phase_s2(const Params& p, const Frame& F, int l) {
    float mshift;
    { const float gq = fabsf(p.in[I_ATT_QN][l * 64 + F.lane]), gk = fabsf(p.in[I_ATT_KN][l * 64 + F.lane]); float mq = gq, mk = gk;
#pragma unroll
      for (int o = 1; o < 64; o <<= 1) { mq = fmaxf(mq, __shfl_xor(mq, o)); mk = fmaxf(mk, __shfl_xor(mk, o)); }
      mshift = 8.0f * mq * mk * 1.4426950408889634f; }
    for (int ci = F.bid; ci < NCHAIN; ci += F.nblk) rwkv_combine(p, F, ci);
    { const int vb = (F.bid + F.nblk - 32) % F.nblk;
      for (int it = vb * 512 + F.tid; it < NCHAIN * 1536; it += F.nblk * 512) ew_combine(p, it); }
#ifndef ATT_REP
#define ATT_REP 1
#endif
    for (int rep = 0; rep < ATT_REP; ++rep)
    if (F.nblk == 256) {
        if (F.bid >= 128) { for (int k = 0; k < 3; ++k) att_item(p, F, F.bid - 128 + 128 * k, mshift); if (F.bid < 160) att_item(p, F, 512 + F.bid - 128, mshift); }
        else att_item(p, F, 384 + F.bid, mshift);
    } else { for (int item = F.bid; item < 544; item += F.nblk) att_item(p, F, item, mshift); }
    if (F.nblk == 256 && F.bid >= 32 && F.bid < 128) { const int gwc = (F.bid - 32) * 8 + F.wave, ngw = 96 * 8;
        phase_conv(p, F, l, 2 | 8 | 32, gwc, ngw); if (l < DEPTH - 1) phase_conv(p, F, l + 1, 1 | 4 | 16, gwc, ngw); }
    else if (F.nblk != 256) { phase_conv(p, F, l, 2 | 8 | 32, F.bid * 8 + F.wave, F.nblk * 8); if (l < DEPTH - 1) phase_conv(p, F, l + 1, 1 | 4 | 16, F.bid * 8 + F.wave, F.nblk * 8); }
}
__device__ __forceinline__ void phase_s3(const Params& p, const Frame& F) {
    for (int it = F.bid; it < 3 * 1088; it += F.nblk) pass3_item(p, F, it);
}
__device__ __forceinline__ void phase_finish(const Params& p, const Frame& F, int l) {
    const bf16_t* U = (const bf16_t*)(p.ws + WS_U); const float* Yg = (const float*)(p.ws + WS_Y); const float* Ys = Yg + (size_t)T * 256; const float* Yr = Ys + (size_t)T * 256;
    const float* XBC = (const float*)(p.ws + WS_XBC); const float* S = (const float*)(p.ws + WS_RW); const float* G = (const float*)(p.ws + WS_G);
    const bf16_t* atto = (const bf16_t*)(p.ws + WS_ATTO);
    bf16_t* cat = (bf16_t*)(p.ws + WS_CAT);
    const int c4 = F.lane * 4, head = F.lane >> 4, hc = c4 & 63;
    const f32x4 glan = *(const f32x4*)(p.in[I_GLA_NORM] + l * 64 + hc), ssmn = *(const f32x4*)(p.in[I_SSM_NORM] + l * 256 + c4);
    const float dsk = p.in[I_SSM_D][l * 4 + head];
    const f32x4 lng = *(const f32x4*)(p.in[I_RW_LNG] + l * 256 + c4), lnb = *(const f32x4*)(p.in[I_RW_LNB] + l * 256 + c4), rk = *(const f32x4*)(p.in[I_RW_RK] + l * 256 + c4);
    const int nw = F.nblk * 8, gw = F.bid * 8 + F.wave;
    const int lo = (int)(((long)gw * T) / nw), hi = (int)(((long)(gw + 1) * T) / nw);
    for (int r0 = lo; r0 < hi; r0 += 2) {
        f32x4 og[2], gt[2], ys[2], xs[2], z[2], yr[2], rr[2], kk[2], vv[2], gg[2]; u32x2 ao[2];
#pragma unroll
        for (int k = 0; k < 2; ++k) { const int r = r0 + k < hi ? r0 + k : hi - 1; const bf16_t* ur = U + (size_t)r * NINP; const float* sb = S + ((size_t)r * 4 + head) * 448 + hc;
            og[k] = *(const f32x4*)(Yg + (size_t)r * 256 + c4); gt[k] = ldbf4(ur + U_GLA_G + c4);
            ys[k] = *(const f32x4*)(Ys + (size_t)r * 256 + c4); xs[k] = *(const f32x4*)(XBC + (size_t)r * 512 + c4); z[k] = ldbf4(ur + U_SSM_Z + c4);
            yr[k] = *(const f32x4*)(Yr + (size_t)r * 256 + c4); rr[k] = *(const f32x4*)(sb); kk[k] = *(const f32x4*)(sb + 192); vv[k] = *(const f32x4*)(sb + 384); gg[k] = *(const f32x4*)(G + (size_t)r * 256 + c4);
            ao[k] = *(const u32x2*)(atto + (size_t)r * 256 + c4); }
#pragma unroll
        for (int k = 0; k < 2; ++k) { const int r = r0 + k; if (r < hi) {
            bf16_t* cr = cat + (size_t)r * D;
            u32x2 w0, w1, w2;
            { const float ss = sum16((og[k].x * og[k].x + og[k].y * og[k].y) + (og[k].z * og[k].z + og[k].w * og[k].w)); const float rs = 1.0f / sqrtf(ss * (1.0f / 64.0f) + 1e-6f);
              f32x4 y;
#pragma unroll
              for (int e = 0; e < 4; ++e) y[e] = og[k][e] * rs * glan[e] * silu_fast2(gt[k][e]);
              w0.x = cvt_pk_bf16(y[0], y[1]); w0.y = cvt_pk_bf16(y[2], y[3]); }
            { f32x4 y; float ss = 0.f;
#pragma unroll
              for (int e = 0; e < 4; ++e) { y[e] = (ys[k][e] + dsk * xs[k][e]) * silu_fast2(z[k][e]); ss += y[e] * y[e]; }
              ss = wave_sum(ss); const float rs = 1.0f / sqrtf(ss * (1.0f / 256.0f) + 1e-6f);
              w1.x = cvt_pk_bf16(y[0] * rs * ssmn[0], y[1] * rs * ssmn[1]); w1.y = cvt_pk_bf16(y[2] * rs * ssmn[2], y[3] * rs * ssmn[3]); }
            { const float mu = sum16((yr[k].x + yr[k].y) + (yr[k].z + yr[k].w)) * (1.0f / 64.0f);
              const f32x4 dlt = yr[k] - mu; const float var = sum16((dlt.x * dlt.x + dlt.y * dlt.y) + (dlt.z * dlt.z + dlt.w * dlt.w)) * (1.0f / 64.0f);
              const float rs = 1.0f / sqrtf(var + 64e-5f);
              const float dot = sum16((rr[k].x * kk[k].x * rk.x + rr[k].y * kk[k].y * rk.y) + (rr[k].z * kk[k].z * rk.z + rr[k].w * kk[k].w * rk.w));
              f32x4 o;
#pragma unroll
              for (int e = 0; e < 4; ++e) o[e] = (dlt[e] * rs * lng[e] + lnb[e] + dot * vv[k][e]) * gg[k][e];
              w2.x = cvt_pk_bf16(o[0], o[1]); w2.y = cvt_pk_bf16(o[2], o[3]); }
            *(u32x2*)(cr + c4) = w0; *(u32x2*)(cr + 256 + c4) = w1; *(u32x2*)(cr + 512 + c4) = w2; *(u32x2*)(cr + 768 + c4) = ao[k]; } }
    }
}
#ifndef EXP
#define EXP 0
#endif
#if EXP == 0
constexpr int NPH_LAYER = 15;
__device__ __forceinline__ int phase_type(int s) { switch (s) { case 0: return 0; case 1: return 1; case 2: return 2; case 3: return 3; case 4: return 4; case 5: return 5; case 6: return 6; case 7: return 7; case 8: return 8; case 9: return 9; case 10: return 10; case 11: return 11; case 12: return 12; case 13: return 13; case 14: return 14; default: return 0; } }
#endif
#if EXP == 1
constexpr int NPH_LAYER = 18;
__device__ __forceinline__ int phase_type(int s) { switch (s) { case 0: return 0; case 1: return 1; case 2: return 2; case 3: return 2; case 4: return 3; case 5: return 4; case 6: return 5; case 7: return 5; case 8: return 6; case 9: return 7; case 10: return 8; case 11: return 9; case 12: return 10; case 13: return 11; case 14: return 12; case 15: return 13; case 16: return 13; case 17: return 14; default: return 0; } }
#endif
#if EXP == 2
constexpr int NPH_LAYER = 20;
__device__ __forceinline__ int phase_type(int s) { switch (s) { case 0: return 0; case 1: return 0; case 2: return 1; case 3: return 1; case 4: return 2; case 5: return 3; case 6: return 4; case 7: return 4; case 8: return 5; case 9: return 6; case 10: return 7; case 11: return 8; case 12: return 9; case 13: return 10; case 14: return 10; case 15: return 11; case 16: return 12; case 17: return 12; case 18: return 13; case 19: return 14; default: return 0; } }
#endif
#if EXP == 3
constexpr int NPH_LAYER = 17;
__device__ __forceinline__ int phase_type(int s) { switch (s) { case 0: return 0; case 1: return 1; case 2: return 2; case 3: return 3; case 4: return 4; case 5: return 5; case 6: return 6; case 7: return 7; case 8: return 6; case 9: return 7; case 10: return 8; case 11: return 9; case 12: return 10; case 13: return 11; case 14: return 12; case 15: return 13; case 16: return 14; default: return 0; } }
#endif
#if EXP == 4
constexpr int NPH_LAYER = 16;
__device__ __forceinline__ int phase_type(int s) { switch (s) { case 0: return 0; case 1: return 1; case 2: return 2; case 3: return 3; case 4: return 4; case 5: return 5; case 6: return 6; case 7: return 6; case 8: return 7; case 9: return 8; case 10: return 9; case 11: return 10; case 12: return 11; case 13: return 12; case 14: return 13; case 15: return 14; default: return 0; } }
#endif
#if EXP == 5
constexpr int NPH_LAYER = 17;
__device__ __forceinline__ int phase_type(int s) { switch (s) { case 0: return 0; case 1: return 1; case 2: return 2; case 3: return 3; case 4: return 4; case 5: return 5; case 6: return 6; case 7: return 7; case 8: return 8; case 9: return 9; case 10: return 10; case 11: return 10; case 12: return 10; case 13: return 11; case 14: return 12; case 15: return 13; case 16: return 14; default: return 0; } }
#endif
#if EXP == 6
constexpr int NPH_LAYER = 20;
__device__ __forceinline__ int phase_type(int s) { switch (s) { case 0: return 0; case 1: return 1; case 2: return 2; case 3: return 3; case 4: return 4; case 5: return 5; case 6: return 6; case 7: return 7; case 8: return 8; case 9: return 9; case 10: return 10; case 11: return 11; case 12: return 12; case 13: return 13; case 14: return 14; case 15: return 99; case 16: return 99; case 17: return 99; case 18: return 99; case 19: return 99; default: return 0; } }
#endif
#if EXP == 7
constexpr int NPH_LAYER = 16;
__device__ __forceinline__ int phase_type(int s) { switch (s) { case 0: return 0; case 1: return 1; case 2: return 2; case 3: return 3; case 4: return 4; case 5: return 5; case 6: return 6; case 7: return 7; case 8: return 7; case 9: return 8; case 10: return 9; case 11: return 10; case 12: return 11; case 13: return 12; case 14: return 13; case 15: return 14; default: return 0; } }
#endif
#if EXP == 8
constexpr int NPH_LAYER = 16;
__device__ __forceinline__ int phase_type(int s) { switch (s) { case 0: return 0; case 1: return 1; case 2: return 2; case 3: return 3; case 4: return 4; case 5: return 5; case 6: return 6; case 7: return 7; case 8: return 70; case 9: return 8; case 10: return 9; case 11: return 10; case 12: return 11; case 13: return 12; case 14: return 13; case 15: return 14; default: return 0; } }
#endif
#if EXP == 9
constexpr int NPH_LAYER = 16;
__device__ __forceinline__ int phase_type(int s) { switch (s) { case 0: return 0; case 1: return 1; case 2: return 2; case 3: return 3; case 4: return 4; case 5: return 5; case 6: return 6; case 7: return 7; case 8: return 71; case 9: return 8; case 10: return 9; case 11: return 10; case 12: return 11; case 13: return 12; case 14: return 13; case 15: return 14; default: return 0; } }
#endif
#if EXP == 10
constexpr int NPH_LAYER = 16;
__device__ __forceinline__ int phase_type(int s) { switch (s) { case 0: return 0; case 1: return 1; case 2: return 2; case 3: return 3; case 4: return 30; case 5: return 4; case 6: return 5; case 7: return 6; case 8: return 7; case 9: return 8; case 10: return 9; case 11: return 10; case 12: return 11; case 13: return 12; case 14: return 13; case 15: return 14; default: return 0; } }
#endif
#if EXP == 11
constexpr int NPH_LAYER = 16;
__device__ __forceinline__ int phase_type(int s) { switch (s) { case 0: return 0; case 1: return 1; case 2: return 2; case 3: return 3; case 4: return 4; case 5: return 5; case 6: return 6; case 7: return 7; case 8: return 8; case 9: return 9; case 10: return 10; case 11: return 11; case 12: return 31; case 13: return 12; case 14: return 13; case 15: return 14; default: return 0; } }
#endif
constexpr int NPHASES = NPH_LAYER * DEPTH;
__global__ void __launch_bounds__(512) mega(Params p0) {
    extern __shared__ __attribute__((aligned(16))) unsigned char lds_raw[];
    cg::grid_group grid = cg::this_grid();
    { volatile LAS unsigned* st0 = (volatile LAS unsigned*)((LAS unsigned char*)lds_raw + 131072); if (threadIdx.x < 2) st0[threadIdx.x] = 0u; }
    __syncthreads();
    const XcdBarrier xbar = xcd_barrier_post((unsigned*)(p0.ws + WS_BAR), (volatile LAS unsigned*)((LAS unsigned char*)lds_raw + 131072));
    for (int ph = p0.ph_lo; ph < p0.ph_hi; ++ph) {
        int tid_ = threadIdx.x; asm volatile("" : "+v"(tid_));
        size_t zoff_ = 0; asm volatile("" : "+s"(zoff_));
        Params p = p0; p.ws = p0.ws + zoff_; p.out = p0.out + zoff_;
        int bid_ = blockIdx.x, nblk_ = gridDim.x; asm volatile("" : "+s"(bid_), "+s"(nblk_));
        Frame F; F.bid = bid_; F.nblk = nblk_; F.lds = (LAS unsigned char*)lds_raw; F.tid = tid_; F.lane = F.tid & 63; F.wave = __builtin_amdgcn_readfirstlane(F.tid >> 6);
        const int l = ph / NPH_LAYER, s = phase_type(ph % NPH_LAYER);
        if (s == 0 && l > 0) continue;
        if (s == 0) {
#ifndef SKIP_A
 if (l == 0) { phase_mod_init(p, F); phase_conv(p, F, 0, 1 | 4 | 16, F.bid * 8 + F.wave, F.nblk * 8); }
#endif
 }
        else if (s == 1 || s == 4 || s == 12) {
#ifndef SKIP_B
 { const int which = s == 1 ? 0 : (s == 4 ? 1 : 2);
   const bool pend = which == 0 ? l > 0 : (which == 1 ? true : l < DEPTH - 1);
   const int pl = which == 0 ? l - 1 : l, pgate = which == 0 ? 8 : (which == 1 ? 2 : 5);
   phase_normmod(p, F, l, which, (l == DEPTH - 1 && s == 12) ? TL : T, pend ? (which == 2 ? 4 : 11) : 0, (const float*)(p.ws + WS_MOD) + (size_t)(pl * 5 + 4) * NMODC + pgate * D, which == 2 ? 1.0f : 0.5f); }
#endif
 }
        else if (s == 2 || s == 13) { const int f = s == 13;
            pg8::Gemm g; g.A = (const bf16_t*)(p.ws + WS_HA); const int Mr = (l == DEPTH - 1 && f) ? TL : T;
            g.Bt = (const bf16_t*)(p.ws + WS_WUP) + (size_t)f * NUP * D; g.M = Mr; g.N = NUP; g.K = D; g.ldk = D;
            pg8::StaticOrder so; so.init(Mr, NUP, F.nblk, F.bid);
            pg8::EpiSwiglu e; e.O = (bf16_t*)(p.ws + WS_HID); e.ldc = DFF;

#ifndef SKIP_C
 pg8::gemm_phase<pg8::EpiSwiglu, pg8::StaticOrder, false>(F.lds, g, so, e, nullptr);
#endif
 }
        else if (s == 3 || s == 14 || s == 11 || s == 30 || s == 31) { const int f = s == 14; const bool isout = s == 11 || s == 31; const bool probe = s >= 30;
            pg8::Gemm g; g.A = isout ? (const bf16_t*)(p.ws + WS_CAT) : (const bf16_t*)(p.ws + WS_HID);
            g.Bt = isout ? (const bf16_t*)(p.ws + WS_WOUT) : (const bf16_t*)(p.ws + WS_WDN) + (size_t)f * D * DFF; const int Mr = (l == DEPTH - 1 && (isout || f)) ? TL : T;
            g.M = TL; g.N = D; g.K = isout ? D : DFF; g.ldk = g.K;
            pg8::StaticOrder so; so.init(TL, D, F.nblk, F.bid);
            pg8::EpiResid e; e.xlat = p.out; e.xctx = (float*)(p.ws + WS_XCTX); e.gate = (const float*)(p.ws + WS_MOD) + (size_t)(l * 5) * NMODC + (isout ? 5 : (f ? 8 : 2)) * D; e.coef = probe ? 0.0f : (isout ? 1.0f : 0.5f);

#ifndef SKIP_D
 pg8::gemm_phase<pg8::EpiResid, pg8::StaticOrder, false>(F.lds, g, so, e, nullptr);
#endif
            if (Mr == T && !probe) {
                pg8::Gemm g2 = g; g2.K = 256; g2.ldk = g.K;
                pg8::SliceOrder so2; so2.nslice = g.K / 256; so2.c = F.bid;
                pg8::EpiStorePart e2; e2.part = (float*)(p.ws + WS_U); e2.nslice = so2.nslice;
                pg8::gemm_phase<pg8::EpiStorePart, pg8::SliceOrder, false>(F.lds, g2, so2, e2, nullptr);
            }
 }
        else if (s == 5) {
            pg8::Gemm g; g.A = (const bf16_t*)(p.ws + WS_HA); g.Bt = (const bf16_t*)(p.ws + WS_WIN); g.M = T; g.N = NINP; g.K = D; g.ldk = D;
            pg8::StaticOrder so; so.init(T, NINP, F.nblk, F.bid);
            pg8::EpiStoreBf16 e; e.O = (bf16_t*)(p.ws + WS_U); e.ldc = NINP;

#ifndef SKIP_E
 pg8::gemm_phase<pg8::EpiStoreBf16, pg8::StaticOrder, false>(F.lds, g, so, e, nullptr);
#endif
 }
        else if (s == 6) {
#ifndef SKIP_F
 phase_prep(p, F, l);
#endif
 }
        else if (s == 7) {
#ifndef SKIP_G
 phase_s1(p, F);
#endif
 }
        else if (s == 70) phase_s1(p, F, 0, 1);
        else if (s == 71) phase_s1(p, F, 1, 3);
        else if (s == 8) {
#ifndef SKIP_I
 phase_s2(p, F, l);
#endif
 }
        else if (s == 9) {
#ifndef SKIP_J
 phase_s3(p, F);
#endif
 }
        else if (s == 10) {
#ifndef SKIP_H
 phase_finish(p, F, l);
#endif
 }
        if (ph + 1 < p0.ph_hi) { if (ph == p0.ph_lo) grid.sync(); else xcd_barrier(xbar); }
    }
}

extern "C" void kernel_launch(void* const* d_in, const int* in_sizes, int n_in, void* d_out, int out_size, void* d_ws, size_t ws_size, hipStream_t stream) {
    static int grid_blocks = 0;
    if (!grid_blocks) {
        int dev = 0, cus = 0, per_cu = 0;
        (void)hipGetDevice(&dev);
        (void)hipDeviceGetAttribute(&cus, hipDeviceAttributeMultiprocessorCount, dev);
        (void)hipFuncSetAttribute((const void*)mega, hipFuncAttributeMaxDynamicSharedMemorySize, LDS_BYTES);
        (void)hipOccupancyMaxActiveBlocksPerMultiprocessor(&per_cu, (const void*)mega, 512, LDS_BYTES);
        if (per_cu < 1) per_cu = 1;
        grid_blocks = cus * per_cu;
        if (n_in != N_INPUTS || out_size != TL * D || ws_size < WS_END) { fprintf(stderr, "kernel_launch: unexpected sizes n_in %d out %d ws %zu (need %zu)\n", n_in, out_size, ws_size, (size_t)WS_END); grid_blocks = -1; }
    }
    if (grid_blocks < 0) return;
    Params p{};
    for (int i = 0; i < N_INPUTS; ++i) p.in[i] = (const float*)d_in[i];
    p.out = (float*)d_out; p.ws = (unsigned char*)d_ws; p.ph_lo = 0; p.ph_hi = NPHASES;
    (void)hipMemsetAsync((unsigned char*)d_ws + WS_BAR, 0, 16384, stream);
    void* args[] = {&p};
    hipError_t e = hipLaunchCooperativeKernel((void*)mega, dim3(grid_blocks), dim3(512), args, LDS_BYTES, stream);
    if (e != hipSuccess) fprintf(stderr, "cooperative launch failed: %s (grid %d)\n", hipGetErrorString(e), grid_blocks);
}
```
